# Optimizing an MI355X kernel written in HIP

```python
import jax, jax.numpy as jnp
from jax import lax
import numpy as np

D_MODEL = 1024
BATCH = 2
SEQ = 16384
DEPTH = 2

N_MIXERS = 2
N_NSA_LAYERS = (DEPTH + 1) // 2
N_HG_LAYERS = DEPTH // 2
EPS = 1e-6
ROPE_THETA = 10000.0

NSA_HEADS = 16
NSA_KV_GROUPS = 4
NSA_HPG = NSA_HEADS // NSA_KV_GROUPS
NSA_HEAD_DIM = D_MODEL // NSA_HEADS
NSA_Q_W = NSA_HEADS * NSA_HEAD_DIM
NSA_KV_W = NSA_KV_GROUPS * NSA_HEAD_DIM
NSA_IN = 2 * NSA_Q_W + 6 * NSA_KV_W + 3 * NSA_HEADS
CMP_BLOCK = 32
CMP_STRIDE = 16
CMP_HIDDEN = 4 * NSA_HEAD_DIM
SEL_BLOCK = 64
SEL_TOPK = 16
WINDOW = 512
NSA_QBLOCK = 128

HG_EXPAND = 128
HG_HEADS = D_MODEL // HG_EXPAND
HG_KDIM = HG_EXPAND
HG_VDIM = D_MODEL // HG_HEADS
HG_K_W = HG_HEADS * HG_KDIM
HG_V_W = HG_HEADS * HG_VDIM
HG_IN = 2 * HG_K_W + 2 * HG_V_W
HG_CHUNK = 64

kernel_name = "nsa_hgrn2_interleaved_hybrid"


def rms_norm(x, g):
    xf = x.astype(jnp.float32)
    y = xf * lax.rsqrt(jnp.mean(xf * xf, axis=-1, keepdims=True) + EPS)
    return (y * g.astype(jnp.float32)).astype(x.dtype)


def rope(x, pos):
    half = x.shape[-1] // 2
    inv = ROPE_THETA ** (-jnp.arange(half, dtype=jnp.float32) / half)
    ang = pos.astype(jnp.float32)[:, None] * inv[None, :]
    cos = jnp.cos(ang)[:, None, :]
    sin = jnp.sin(ang)[:, None, :]
    xf = x.astype(jnp.float32)
    x1, x2 = xf[..., :half], xf[..., half:]
    return jnp.concatenate([x1 * cos - x2 * sin, x2 * cos + x1 * sin], axis=-1).astype(x.dtype)


def masked_softmax(s, mask):
    p = jax.nn.softmax(jnp.where(mask, s, -1e30), axis=-1)
    return jnp.where(mask, p, 0.0)


def split_cols(a, sizes):
    offs = np.cumsum(sizes)[:-1].tolist()
    return jnp.split(a, offs, axis=-1)


def compress(kv, pe, w1, w2):
    B, S, G, hd = kv.shape
    n_cmp = (S - CMP_BLOCK) // CMP_STRIDE + 1
    idx = jnp.arange(n_cmp)[:, None] * CMP_STRIDE + jnp.arange(CMP_BLOCK)[None, :]
    blocks = kv[:, idx] + pe[:, None, :]
    flat = jnp.moveaxis(blocks, 3, 2).reshape(B, n_cmp, G, CMP_BLOCK * hd)
    return jax.nn.silu(flat @ w1) @ w2


def nsa_mixer(h, w_in, pe_k, pe_v, wk1, wk2, wv1, wv2, w_out):
    B, S, _ = h.shape
    H, G, R, hd = NSA_HEADS, NSA_KV_GROUPS, NSA_HPG, NSA_HEAD_DIM
    QB = NSA_QBLOCK
    scale = hd ** -0.5
    pos = jnp.arange(S)
    proj = h @ w_in
    q, kc, vc, ks, vs, kw, vw, gl, z = split_cols(proj, [NSA_Q_W] + [NSA_KV_W] * 6 + [3 * H, NSA_Q_W])
    q = rope(q.reshape(B, S, H, hd), pos).reshape(B, S, G, R, hd)
    gates = jax.nn.sigmoid(gl.astype(jnp.float32)).reshape(B, S, G, R, 3)
    kv = lambda a: a.reshape(B, S, G, hd)

    v_cmp = compress(kv(vc), pe_v, wv1, wv2)
    k_raw = compress(kv(kc), pe_k, wk1, wk2)
    n_cmp = k_raw.shape[1]
    cmp_start = jnp.arange(n_cmp) * CMP_STRIDE
    cmp_end = cmp_start + CMP_BLOCK - 1
    k_cmp = rope(k_raw, cmp_end)

    n_sel = S // SEL_BLOCK
    n_top = min(SEL_TOPK, n_sel)
    ks_blk = rope(kv(ks), pos).reshape(B, n_sel, SEL_BLOCK, G, hd).transpose(0, 3, 1, 2, 4)
    vs_blk = kv(vs).reshape(B, n_sel, SEL_BLOCK, G, hd).transpose(0, 3, 1, 2, 4)
    sel_start = jnp.arange(n_sel) * SEL_BLOCK
    overlap = ((cmp_start[:, None] < sel_start[None, :] + SEL_BLOCK)
               & (cmp_start[:, None] + CMP_BLOCK > sel_start[None, :])).astype(jnp.float32)
    bidx = jnp.arange(B)[:, None, None, None]
    gidx = jnp.arange(G)[None, None, :, None]
    sel_ids = jnp.arange(n_sel)

    pad = ((0, 0), (WINDOW, 0), (0, 0), (0, 0))
    kw_p = jnp.pad(rope(kv(kw), pos), pad)
    vw_p = jnp.pad(kv(vw), pad)

    def block_fn(s0):
        t = s0 + jnp.arange(QB)
        qb = lax.dynamic_slice_in_dim(q, s0, QB, axis=1)
        gb = lax.dynamic_slice_in_dim(gates, s0, QB, axis=1)
        sc = jnp.einsum('bqgrd,bngd->bqgrn', qb, k_cmp).astype(jnp.float32) * scale
        m_c = (cmp_end[None, :] <= t[:, None])[None, :, None, None, :]
        p_c = masked_softmax(sc, m_c)
        o_c = jnp.einsum('bqgrn,bngd->bqgrd', p_c.astype(v_cmp.dtype), v_cmp)
        imp = jnp.einsum('bqgrn,nj->bqgj', p_c, overlap)
        cur = t // SEL_BLOCK
        valid = sel_ids[None, :] <= cur[:, None]
        forced = (sel_ids[None, :] == 0) | (sel_ids[None, :] == cur[:, None]) | (sel_ids[None, :] == cur[:, None] - 1)
        score = jnp.where(forced[None, :, None, :], jnp.inf,
                          jnp.where(valid[None, :, None, :], imp, -jnp.inf))
        _, idx = lax.top_k(score, n_top)
        k_sel = ks_blk[bidx, gidx, idx].reshape(B, QB, G, n_top * SEL_BLOCK, hd)
        v_sel = vs_blk[bidx, gidx, idx].reshape(B, QB, G, n_top * SEL_BLOCK, hd)
        pos_sel = (idx[..., None] * SEL_BLOCK + jnp.arange(SEL_BLOCK)).reshape(B, QB, G, 1, n_top * SEL_BLOCK)
        m_s = pos_sel <= t[None, :, None, None, None]
        ss = jnp.einsum('bqgrd,bqgmd->bqgrm', qb, k_sel).astype(jnp.float32) * scale
        p_s = masked_softmax(ss, m_s)
        o_s = jnp.einsum('bqgrm,bqgmd->bqgrd', p_s.astype(v_sel.dtype), v_sel)
        kwb = lax.dynamic_slice_in_dim(kw_p, s0, WINDOW + QB, axis=1)
        vwb = lax.dynamic_slice_in_dim(vw_p, s0, WINDOW + QB, axis=1)
        pos_w = s0 - WINDOW + jnp.arange(WINDOW + QB)
        dlt = t[:, None] - pos_w[None, :]
        m_w = ((pos_w[None, :] >= 0) & (dlt >= 0) & (dlt < WINDOW))[None, :, None, None, :]
        sw = jnp.einsum('bqgrd,bkgd->bqgrk', qb, kwb).astype(jnp.float32) * scale
        p_w = masked_softmax(sw, m_w)
        o_w = jnp.einsum('bqgrk,bkgd->bqgrd', p_w.astype(vwb.dtype), vwb)
        o = gb[..., 0:1] * o_c + gb[..., 1:2] * o_s + gb[..., 2:3] * o_w
        return o.astype(h.dtype)

    o = lax.map(block_fn, jnp.arange(S // QB) * QB)
    o = o.transpose(1, 0, 2, 3, 4, 5).reshape(B, S, NSA_Q_W)
    return (o * jax.nn.silu(z)) @ w_out


def hgrn2_mixer(h, w_in, lb, g_norm, w_out):
    B, S, _ = h.shape
    H, dk, dv, C = HG_HEADS, HG_KDIM, HG_VDIM, HG_CHUNK
    NC = S // C
    proj = h @ w_in
    q_raw, f_raw, i_in, z = split_cols(proj, [HG_K_W, HG_K_W, HG_V_W, HG_V_W])
    q = jax.nn.silu(q_raw.astype(jnp.float32)).reshape(B, S, H, dk)
    f = lb[None, None, :] + (1.0 - lb[None, None, :]) * jax.nn.sigmoid(f_raw.astype(jnp.float32))
    k = (1.0 - f).reshape(B, S, H, dk)
    logf = jnp.log(f).reshape(B, S, H, dk)
    v = i_in.astype(jnp.float32).reshape(B, S, H, dv)
    to_chunks = lambda a: a.reshape(B, NC, C, H, a.shape[-1]).transpose(1, 0, 3, 2, 4)
    causal = jnp.tril(jnp.ones((C, C), dtype=bool))

    def step(state, inp):
        qc, kc, vc, lfc = inp
        b = jnp.cumsum(lfc, axis=2)
        o_inter = jnp.einsum('bhtk,bhkv->bhtv', qc * jnp.exp(b), state)
        diff = b[:, :, :, None, :] - b[:, :, None, :, :]
        decay = jnp.exp(jnp.where(causal[:, :, None], diff, -jnp.inf))
        att = jnp.einsum('bhtk,bhsk,bhtsk->bhts', qc, kc, decay)
        o = o_inter + jnp.einsum('bhts,bhsv->bhtv', att, vc)
        b_last = b[:, :, -1:, :]
        new_state = jnp.exp(b_last[:, :, 0, :])[..., None] * state + jnp.einsum(
            'bhsk,bhsv->bhkv', kc * jnp.exp(b_last - b), vc)
        return new_state, o

    state0 = jnp.zeros((B, H, dk, dv), jnp.float32)
    _, o = lax.scan(step, state0, (to_chunks(q), to_chunks(k), to_chunks(v), to_chunks(logf)))
    o = o.transpose(1, 0, 3, 2, 4).reshape(B, S, H, dv)
    o = o * lax.rsqrt(jnp.mean(o * o, axis=-1, keepdims=True) + EPS)
    o = (o.reshape(B, S, HG_V_W) * g_norm.astype(jnp.float32)).astype(h.dtype)
    return (o * jax.nn.silu(z)) @ w_out


def setup_inputs(seed: int = 0) -> dict:
    key = jax.random.key(seed)
    ks = jax.random.split(key, 16)
    nrm = lambda k, shape: jax.random.normal(k, shape, jnp.float32)
    w = lambda k, shape, fan_in: nrm(k, shape) * fan_in ** -0.5
    hd = NSA_HEAD_DIM
    return {
        "x": nrm(ks[0], (BATCH, SEQ, D_MODEL)),
        "norm_w": 1.0 + 0.01 * nrm(ks[1], (DEPTH, D_MODEL)),
        "nsa_w_in": w(ks[2], (N_NSA_LAYERS, D_MODEL, NSA_IN), D_MODEL),
        "nsa_pe_k": 0.02 * nrm(ks[3], (N_NSA_LAYERS, CMP_BLOCK, hd)),
        "nsa_pe_v": 0.02 * nrm(ks[4], (N_NSA_LAYERS, CMP_BLOCK, hd)),
        "nsa_wk1": w(ks[5], (N_NSA_LAYERS, CMP_BLOCK * hd, CMP_HIDDEN), CMP_BLOCK * hd),
        "nsa_wk2": w(ks[6], (N_NSA_LAYERS, CMP_HIDDEN, hd), CMP_HIDDEN),
        "nsa_wv1": w(ks[7], (N_NSA_LAYERS, CMP_BLOCK * hd, CMP_HIDDEN), CMP_BLOCK * hd),
        "nsa_wv2": w(ks[8], (N_NSA_LAYERS, CMP_HIDDEN, hd), CMP_HIDDEN),
        "nsa_w_out": w(ks[9], (N_NSA_LAYERS, NSA_Q_W, D_MODEL), NSA_Q_W),
        "hg_w_in": w(ks[10], (N_HG_LAYERS, D_MODEL, HG_IN), D_MODEL),
        "hg_lb_logits": 0.5 * nrm(ks[11], (DEPTH, HG_K_W)),
        "hg_norm": 1.0 + 0.01 * nrm(ks[12], (N_HG_LAYERS, HG_V_W)),
        "hg_w_out": w(ks[13], (N_HG_LAYERS, HG_V_W, D_MODEL), HG_V_W),
        "final_norm": 1.0 + 0.01 * nrm(ks[14], (D_MODEL,)),
    }


def reference(x, norm_w, nsa_w_in, nsa_pe_k, nsa_pe_v, nsa_wk1, nsa_wk2, nsa_wv1, nsa_wv2,
              nsa_w_out, hg_w_in, hg_lb_logits, hg_norm, hg_w_out, final_norm):
    p = jax.nn.softmax(hg_lb_logits.astype(jnp.float32), axis=0)
    lower_bounds = jnp.cumsum(p, axis=0) - p[0]
    for i in range(DEPTH):
        h = rms_norm(x, norm_w[i])
        j = i // N_MIXERS
        if i % N_MIXERS == 0:
            y = nsa_mixer(h, nsa_w_in[j], nsa_pe_k[j], nsa_pe_v[j], nsa_wk1[j], nsa_wk2[j],
                          nsa_wv1[j], nsa_wv2[j], nsa_w_out[j])
        else:
            y = hgrn2_mixer(h, hg_w_in[j], lower_bounds[i], hg_norm[j], hg_w_out[j])
        x = x + y.astype(x.dtype)
    return rms_norm(x, final_norm)
```

```cpp
#include <hip/hip_runtime.h>
#include <hip/hip_cooperative_groups.h>
#include <cstdio>
#include <type_traits>
namespace cg = cooperative_groups;

#define DI __device__ __forceinline__
typedef unsigned short u16;
typedef __attribute__((ext_vector_type(8))) short bf16x8;
typedef __attribute__((ext_vector_type(4))) float f32x4;
typedef __attribute__((ext_vector_type(16))) float f32x16;

constexpr int NTHR = 512;
constexpr int SEQ = 16384;
constexpr int NTOK = 32768;
constexpr int NSA_NP = 3840;
constexpr float EPSV = 1e-6f;
constexpr int DYN_LDS = 131072;
#ifndef PHASES
#define PHASES 0xffff
#endif
#ifndef REPEAT
#define REPEAT 0
#endif
#define PH(n) if ((PHASES >> (n)) & 1) for (int rep_ = 0; rep_ < (((REPEAT >> (n)) & 1) ? 2 : 1); ++rep_)

constexpr size_t MiB = 1u << 20;
constexpr size_t OFF_WT_NSA_IN = 0;
constexpr size_t OFF_WT_HG_IN = 8 * MiB;
constexpr size_t OFF_WT_NSA_OUT = 16 * MiB;
constexpr size_t OFF_WT_HG_OUT = 18 * MiB;
constexpr size_t OFF_WT_K1 = 20 * MiB;
constexpr size_t OFF_WT_V1 = 21 * MiB;
constexpr size_t OFF_ROPE = 22 * MiB;
constexpr size_t OFF_MISC = 26 * MiB;
constexpr size_t ARENA = 27 * MiB;
constexpr size_t OFF_H = ARENA;
constexpr size_t OFF_Q = ARENA + 64 * MiB;
constexpr size_t OFF_KC = ARENA + 128 * MiB;
constexpr size_t OFF_VC = ARENA + 144 * MiB;
constexpr size_t OFF_KS = ARENA + 160 * MiB;
constexpr size_t OFF_VST = ARENA + 176 * MiB;
constexpr size_t OFF_KW = ARENA + 192 * MiB;
constexpr size_t OFF_VWT = ARENA + 208 * MiB;
constexpr size_t OFF_SZ = ARENA + 224 * MiB;
constexpr size_t OFF_GATES = ARENA + 288 * MiB;
constexpr size_t OFF_HID = ARENA + 296 * MiB;
constexpr size_t OFF_KCMP = ARENA + 304 * MiB;
constexpr size_t OFF_VCMPT = ARENA + 305 * MiB;
constexpr size_t OFF_O = ARENA + 306 * MiB;
constexpr size_t OFF_STATES = ARENA;
constexpr size_t OFF_QH = ARENA + 128 * MiB;
constexpr size_t OFF_LOGF = ARENA + 192 * MiB;
constexpr size_t OFF_VH = ARENA + 320 * MiB;
constexpr size_t OFF_SZH = ARENA + 384 * MiB;
constexpr size_t OFF_DC = ARENA + 448 * MiB;
constexpr size_t WS_NEED = ARENA + 450 * MiB;

struct Params {
  const float *x, *norm_w, *nsa_w_in, *pe_k, *pe_v, *wk1, *wk2, *wv1, *wv2, *nsa_w_out, *hg_w_in, *lb_logits, *hg_norm,
      *hg_w_out, *final_norm;
  float* out;
  char* ws;
};

DI u16 f2bf(float f) {
  unsigned u = __float_as_uint(f);
  u += 0x7fffu + ((u >> 16) & 1u);
  return (u16)(u >> 16);
}
DI float bf2f(u16 h) { return __uint_as_float(((unsigned)h) << 16); }
typedef __attribute__((ext_vector_type(2))) float f32x2_;
typedef __attribute__((ext_vector_type(2))) __bf16 bf16x2_;
DI unsigned pack2(float a, float b) {
  f32x2_ v = {a, b};
  return __builtin_bit_cast(unsigned, __builtin_convertvector(v, bf16x2_));
}
DI float exp2f_(float x) { return __builtin_amdgcn_exp2f(x); }
DI float dpp_xor1(float v) { return __builtin_bit_cast(float, __builtin_amdgcn_mov_dpp(__builtin_bit_cast(int, v), 0xB1, 0xf, 0xf, true)); }
DI float dpp_xor2(float v) { return __builtin_bit_cast(float, __builtin_amdgcn_mov_dpp(__builtin_bit_cast(int, v), 0x4E, 0xf, 0xf, true)); }
DI float bflo(unsigned u) { return __uint_as_float(u << 16); }
DI float bfhi(unsigned u) { return __uint_as_float(u & 0xffff0000u); }
DI float sigmoidf_(float x) { return __builtin_amdgcn_rcpf(1.f + __expf(-x)); }
DI float siluf_(float x) { return x * __builtin_amdgcn_rcpf(1.f + __expf(-x)); }
DI float wave_sum(float v) {
#pragma unroll
  for (int o = 32; o > 0; o >>= 1) v += __shfl_xor(v, o);
  return v;
}
DI f32x4 mfma16(bf16x8 a, bf16x8 b, f32x4 c) { return __builtin_amdgcn_mfma_f32_16x16x32_bf16(a, b, c, 0, 0, 0); }
DI bf16x8 pack8(f32x4 lo, f32x4 hi) {
  uint4 u;
  u.x = pack2(lo[0], lo[1]);
  u.y = pack2(lo[2], lo[3]);
  u.z = pack2(hi[0], hi[1]);
  u.w = pack2(hi[2], hi[3]);
  return __builtin_bit_cast(bf16x8, u);
}
DI bf16x8 ld8(const u16* p) { return *(const bf16x8*)p; }
DI bf16x8 ld4x2(const u16* p0, const u16* p1) {
  uint2 a = *(const uint2*)p0;
  uint2 b = *(const uint2*)p1;
  uint4 u = make_uint4(a.x, a.y, b.x, b.y);
  return __builtin_bit_cast(bf16x8, u);
}

extern __shared__ __attribute__((aligned(16))) char dyn_lds[];
#define RAW_BARRIER()                                   \
  do {                                                  \
    asm volatile("s_waitcnt lgkmcnt(0)" ::: "memory"); \
    __builtin_amdgcn_s_barrier();                       \
  } while (0)
template <bool PRE12 = true, class AF, class EF>
DI void gemm_tile256(char* smem, const int tid, AF afn, const u16* __restrict__ Bt, int K, int m0, int n0, EF epi) {
  const int lane = tid & 63, wave = tid >> 6;
  const int wm = wave >> 1, wn = wave & 1;
  f32x16 acc[2][4];
#pragma unroll
  for (int mi = 0; mi < 2; ++mi)
#pragma unroll
    for (int ni = 0; ni < 4; ++ni)
#pragma unroll
      for (int i = 0; i < 16; ++i) acc[mi][ni][i] = 0.f;
  const int KT = K >> 5;
  const int r0 = wave * 16 + (lane >> 2), r1 = r0 + 128;
  const int c0 = ((lane & 3) ^ ((r0 >> 2) & 3)) * 8, c1 = ((lane & 3) ^ ((r1 >> 2) & 3)) * 8;
  const u16* gb0 = Bt + (size_t)(n0 + r0) * K + c0;
  const u16* gb1 = Bt + (size_t)(n0 + r1) * K + c1;
  auto glds = [&](int kt, int st) {
    char* sb = dyn_lds + st * 32768 + wave * 1024;
    __builtin_amdgcn_global_load_lds((const unsigned*)afn(m0 + r0, kt * 32 + c0), (unsigned*)(sb), 16, 0, 0);
    __builtin_amdgcn_global_load_lds((const unsigned*)afn(m0 + r1, kt * 32 + c1), (unsigned*)(sb + 8192), 16, 0, 0);
    __builtin_amdgcn_global_load_lds((const unsigned*)(gb0 + kt * 32), (unsigned*)(sb + 16384), 16, 0, 0);
    __builtin_amdgcn_global_load_lds((const unsigned*)(gb1 + kt * 32), (unsigned*)(sb + 16384 + 8192), 16, 0, 0);
  };
  __syncthreads();
  glds(0, 0);
  if (KT > 1) glds(1, 1);
  if (KT > 2) glds(2, 2);
  const int l31 = lane & 31, lh = lane >> 5;
  for (int kt = 0; kt < KT; ++kt) {
    if (kt + 2 < KT) asm volatile("s_waitcnt vmcnt(8)" ::: "memory");
    else if (kt + 1 < KT) asm volatile("s_waitcnt vmcnt(4)" ::: "memory");
    else asm volatile("s_waitcnt vmcnt(0)" ::: "memory");
    RAW_BARRIER();
    if (kt + 3 < KT) glds(kt + 3, (kt + 3) & 3);
    const char* cA = dyn_lds + (kt & 3) * 32768;
    const char* cB = cA + 16384;
    {
      bf16x8 af0[2], bf0[4], af1[2], bf1[4];
      auto rd = [&](bf16x8 (&af)[2], bf16x8 (&bfr)[4], int ks) {
        const int ch = ks * 2 + lh;
#pragma unroll
        for (int mi = 0; mi < 2; ++mi) {
          const int row = wm * 64 + mi * 32 + l31;
          af[mi] = *(const bf16x8*)(cA + row * 64 + ((ch ^ ((row >> 2) & 3)) << 4));
        }
#pragma unroll
        for (int ni = 0; ni < 4; ++ni) {
          const int row = wn * 128 + ni * 32 + l31;
          bfr[ni] = *(const bf16x8*)(cB + row * 64 + ((ch ^ ((row >> 2) & 3)) << 4));
        }
      };
      auto mm = [&](const bf16x8 (&af)[2], const bf16x8 (&bfr)[4]) {
#pragma unroll
        for (int mi = 0; mi < 2; ++mi)
#pragma unroll
          for (int ni = 0; ni < 4; ++ni)
            acc[mi][ni] = __builtin_amdgcn_mfma_f32_32x32x16_bf16(af[mi], bfr[ni], acc[mi][ni], 0, 0, 0);
      };
      if (PRE12) {
        rd(af0, bf0, 0);
        rd(af1, bf1, 1);
        __builtin_amdgcn_sched_barrier(0);
        mm(af0, bf0);
        mm(af1, bf1);
      } else {
        rd(af0, bf0, 0);
        mm(af0, bf0);
        rd(af0, bf0, 1);
        mm(af0, bf0);
      }
    }
  }
  RAW_BARRIER();
  epi(acc, m0 + wm * 64, n0 + wn * 128, std::integral_constant<int, 0>());
  epi(acc, m0 + wm * 64, n0 + wn * 128 + 64, std::integral_constant<int, 2>());
}

struct F2 {
  float a, b;
};
DI int vperm_pos(int key64) {
  const int a = key64 >> 5, w = key64 & 31;
  return a * 32 + ((w & 15) >> 2) * 8 + (w & 3) + ((w >> 4) << 2);
}
DI unsigned cvt4_fp8(float a, float b, float c, float d) {
  int w = __builtin_amdgcn_cvt_pk_fp8_f32(a, b, 0, false);
  w = __builtin_amdgcn_cvt_pk_fp8_f32(c, d, w, true);
  return (unsigned)w;
}
DI uint2 bf8_to_fp8(uint4 u) {
  uint2 r;
  r.x = cvt4_fp8(bflo(u.x), bfhi(u.x), bflo(u.y), bfhi(u.y));
  r.y = cvt4_fp8(bflo(u.z), bfhi(u.z), bflo(u.w), bfhi(u.w));
  return r;
}
template <int MODE, bool FP8 = false, class VF>
DI void stage_out(char* wlds, int lane, VF vf, u16* __restrict__ dst, int ld) {
  asm volatile("" : "+v"(lane)::"memory");
  const int l31 = lane & 31, lh = lane >> 5;
  if (MODE != 2) {
    const int w0 = (lh * 4 + 0) * 128 + (((l31 >> 3) ^ (lh * 4 + 0)) << 4) + (l31 & 7) * 2;
    const int w1 = (lh * 4 + 1) * 128 + (((l31 >> 3) ^ (lh * 4 + 1)) << 4) + (l31 & 7) * 2;
    const int w2 = (lh * 4 + 2) * 128 + (((l31 >> 3) ^ (lh * 4 + 2)) << 4) + (l31 & 7) * 2;
    const int w3 = (lh * 4 + 3) * 128 + (((l31 >> 3) ^ (lh * 4 + 3)) << 4) + (l31 & 7) * 2;
#pragma unroll
    for (int mi = 0; mi < 2; ++mi)
#pragma unroll
      for (int i = 0; i < 16; ++i) {
        const F2 v = vf(mi, i);
        const unsigned pk = pack2(v.a, v.b);
        const int wj = (i & 3) == 0 ? w0 : ((i & 3) == 1 ? w1 : ((i & 3) == 2 ? w2 : w3));
        const int cofs = (mi * 32 + (i >> 2) * 8) * 128;
        *(u16*)(wlds + wj + cofs) = (u16)(pk & 0xffffu);
        *(u16*)(wlds + (wj ^ 64) + cofs) = (u16)(pk >> 16);
        if ((i & 1) == 1) asm volatile("" ::: "memory");
      }
  } else {
#pragma unroll
    for (int mi = 0; mi < 2; ++mi)
#pragma unroll
      for (int i4 = 0; i4 < 4; ++i4) {
        const int key0 = mi * 32 + i4 * 8 + lh * 4;
        const int slot0 = vperm_pos(key0);
        const F2 v0 = vf(mi, i4 * 4 + 0), v1 = vf(mi, i4 * 4 + 1), v2 = vf(mi, i4 * 4 + 2), v3 = vf(mi, i4 * 4 + 3);
        uint2 oa, ob;
        oa.x = pack2(v0.a, v1.a);
        oa.y = pack2(v2.a, v3.a);
        ob.x = pack2(v0.b, v1.b);
        ob.y = pack2(v2.b, v3.b);
        const int da = l31, db = 32 + l31;
        *(uint2*)(wlds + da * 128 + (((slot0 >> 3) ^ (da & 7)) << 4) + (slot0 & 7) * 2) = oa;
        *(uint2*)(wlds + db * 128 + (((slot0 >> 3) ^ (db & 7)) << 4) + (slot0 & 7) * 2) = ob;
        asm volatile("" ::: "memory");
      }
  }
  asm volatile("" ::: "memory");
  __builtin_amdgcn_wave_barrier();
  if (MODE == 0) {
#pragma unroll
    for (int it = 0; it < 8; ++it) {
      const int row = it * 8 + (lane >> 3), ch = lane & 7;
      const uint4 v = *(const uint4*)(wlds + row * 128 + ((ch ^ (row & 7)) << 4));
      *(uint4*)(dst + (size_t)row * ld + ch * 8) = v;
    }
  } else if (FP8) {
#pragma unroll
    for (int it = 0; it < 4; ++it) {
      const int r = lane;
      const uint4 v0 = *(const uint4*)(wlds + r * 128 + ((it ^ (r & 7)) << 4));
      const uint4 v1 = *(const uint4*)(wlds + r * 128 + (((it + 4) ^ (r & 7)) << 4));
      const uint2 c0 = bf8_to_fp8(v0), c1 = bf8_to_fp8(v1);
      *(uint4*)((char*)dst + (((r >> 4) * 64 + it * 16 + (r & 15)) * 16)) = make_uint4(c0.x, c0.y, c1.x, c1.y);
    }
  } else {
#pragma unroll
    for (int it = 0; it < 8; ++it) {
      const int r = lane;
      const uint4 v = *(const uint4*)(wlds + r * 128 + ((it ^ (r & 7)) << 4));
      const int off = MODE == 1 ? ((((r >> 4) * 2 + (it >> 2)) * 64 + (it & 3) * 16 + (r & 15)) * 8)
                                : ((((it >> 2) * 4 + (r >> 4)) * 64 + (it & 3) * 16 + (r & 15)) * 8);
      *(uint4*)(dst + off) = v;
    }
  }
  asm volatile("" ::: "memory");
  __builtin_amdgcn_wave_barrier();
}

template <int NIO>
DI void stage_add_f32(char* wlds, int lane, const f32x16 (&accf)[2][4], const float* src, float* dst, int ld) {
  asm volatile("" : "+v"(lane)::"memory");
  const int l31 = lane & 31, lh = lane >> 5;
  float* wf = (float*)wlds;
#pragma unroll
  for (int mi = 0; mi < 2; ++mi)
#pragma unroll
    for (int ni = 0; ni < 2; ++ni)
#pragma unroll
      for (int i = 0; i < 16; ++i) wf[(mi * 32 + (i >> 2) * 8 + lh * 4 + (i & 3)) * 64 + ni * 32 + l31] = accf[mi][NIO + ni][i];
  asm volatile("" ::: "memory");
  __builtin_amdgcn_wave_barrier();
  const int r0 = lane >> 4, c4 = lane & 15;
#pragma unroll
  for (int hb = 0; hb < 4; ++hb) {
    float4 xv[4];
#pragma unroll
    for (int it = 0; it < 4; ++it) xv[it] = *(const float4*)(src + (size_t)((hb * 4 + it) * 4 + r0) * ld + c4 * 4);
#pragma unroll
    for (int it = 0; it < 4; ++it) {
      const int row = (hb * 4 + it) * 4 + r0;
      const float4 a = *(const float4*)(wf + row * 64 + c4 * 4);
      *(float4*)(dst + (size_t)row * ld + c4 * 4) = make_float4(xv[it].x + a.x, xv[it].y + a.y, xv[it].z + a.z, xv[it].w + a.w);
    }
  }
  asm volatile("" ::: "memory");
  __builtin_amdgcn_wave_barrier();
}

template <class CM>
DI void transpose_w(char* smem, const int tid, const float* __restrict__ src, int srcN, u16* __restrict__ dst, int K, int Ndst, CM colmap) {
  float* tile = (float*)smem;
  const int nkt = K >> 6, nnt = Ndst >> 6;
  for (int t = blockIdx.x; t < nkt * nnt; t += gridDim.x) {
    const int kt = t % nkt, nt = t / nkt;
#pragma unroll
    for (int r = 0; r < 8; ++r) {
      const int i = (tid >> 6) + 8 * r, j = tid & 63;
      const int sc = colmap(nt * 64 + j);
      tile[i * 65 + j] = sc >= 0 ? src[(size_t)(kt * 64 + i) * srcN + sc] : 0.f;
    }
    __syncthreads();
#pragma unroll
    for (int r = 0; r < 8; ++r) {
      const int jj = (tid >> 6) + 8 * r, ii = tid & 63;
      dst[(size_t)(nt * 64 + jj) * K + kt * 64 + ii] = f2bf(tile[ii * 65 + jj]);
    }
    __syncthreads();
  }
}

DI void rmsnorm_to_bf16(const float* __restrict__ src, const float* __restrict__ g, u16* __restrict__ dst, int gw, int nw, const int lane) {
  for (int row = gw; row < NTOK; row += nw) {
    const float4* sp = (const float4*)(src + (size_t)row * 1024);
    float4 v[4];
    float ss = 0.f;
#pragma unroll
    for (int i = 0; i < 4; ++i) {
      v[i] = sp[lane + 64 * i];
      ss += v[i].x * v[i].x + v[i].y * v[i].y + v[i].z * v[i].z + v[i].w * v[i].w;
    }
    ss = wave_sum(ss);
    const float rstd = rsqrtf(ss * (1.f / 1024.f) + EPSV);
#pragma unroll
    for (int i = 0; i < 4; ++i) {
      const float4 gg = ((const float4*)g)[lane + 64 * i];
      uint2 o;
      o.x = pack2(v[i].x * rstd * gg.x, v[i].y * rstd * gg.y);
      o.y = pack2(v[i].z * rstd * gg.z, v[i].w * rstd * gg.w);
      *(uint2*)(dst + (size_t)row * 1024 + (lane + 64 * i) * 4) = o;
    }
  }
}

DI void sincos_reduced(double a, float& c, float& s) {
  const double inv2pi = 0.15915494309189533577;
  const double tp_hi = 6.283185307179586232, tp_lo = 2.4492935982947064e-16;
  double n = rint(a * inv2pi);
  double r = fma(-n, tp_hi, a);
  r = fma(-n, tp_lo, r);
  const double r2 = r * r;
  double sp = 0.0, cp = 0.0;
  double fs = 1.0;
  const double SC[13] = {1.0,
                         -1.0 / 6.0,
                         1.0 / 120.0,
                         -1.0 / 5040.0,
                         1.0 / 362880.0,
                         -1.0 / 39916800.0,
                         1.0 / 6227020800.0,
                         -1.0 / 1307674368000.0,
                         1.0 / 355687428096000.0,
                         -1.0 / 121645100408832000.0,
                         1.0 / 51090942171709440000.0,
                         -1.0 / 25852016738884976640000.0,
                         1.0 / 15511210043330985984000000.0};
  const double CC[13] = {1.0,
                         -1.0 / 2.0,
                         1.0 / 24.0,
                         -1.0 / 720.0,
                         1.0 / 40320.0,
                         -1.0 / 3628800.0,
                         1.0 / 479001600.0,
                         -1.0 / 87178291200.0,
                         1.0 / 20922789888000.0,
                         -1.0 / 6402373705728000.0,
                         1.0 / 2432902008176640000.0,
                         -1.0 / 1124000727777607680000.0,
                         1.0 / 620448401733239439360000.0};
  (void)fs;
#pragma unroll
  for (int k = 12; k >= 0; --k) {
    sp = sp * r2 + SC[k];
    cp = cp * r2 + CC[k];
  }
  s = (float)(sp * r);
  c = (float)cp;
}

struct SMState {
  float m, l;
  f32x4 o[4];
};
struct KVFrag {
  bf16x8 k[8];
  bf16x8 v[8];
};
DI int kfrag_off(int key, int dim) {
  return ((((key >> 4) * 2 + (dim >> 5)) * 64) + ((dim >> 3) & 3) * 16 + (key & 15)) * 8 + (dim & 7);
}
DI int vfrag_off(int d, int key) {
  const int w = key & 31;
  return ((((key >> 5) * 4 + (d >> 4)) * 64) + ((w & 15) >> 2) * 16 + (d & 15)) * 8 + (w & 3) + ((w >> 4) << 2);
}
DI void load_k(KVFrag& f, const u16* __restrict__ kbase, int c, int q4) {
  const u16* p = kbase + (q4 * 16 + c) * 8;
#pragma unroll
  for (int fr = 0; fr < 8; ++fr) f.k[fr] = ld8(p + fr * 512);
}
DI void load_v(KVFrag& f, const u16* __restrict__ vtbase, int c, int q4) {
  const u16* p = vtbase + (q4 * 16 + c) * 8;
#pragma unroll
  for (int fr = 0; fr < 8; ++fr) f.v[fr] = ld8(p + fr * 512);
}
DI void qk_scores(f32x4 (&s)[4], const KVFrag& f, const bf16x8 (&qf)[2]) {
#pragma unroll
  for (int st = 0; st < 4; ++st) {
    f32x4 z = {0.f, 0.f, 0.f, 0.f};
    z = mfma16(f.k[st * 2], qf[0], z);
    z = mfma16(f.k[st * 2 + 1], qf[1], z);
    s[st] = z;
  }
}
template <bool MASKED>
DI void attn_compute(SMState& st, const KVFrag& f, const bf16x8 (&qf)[2], int pos0, int tlo, int thi, bool active, int q4) {
  f32x4 s[4];
  qk_scores(s, f, qf);
  if (MASKED) {
#pragma unroll
    for (int t4 = 0; t4 < 4; ++t4)
#pragma unroll
      for (int i = 0; i < 4; ++i) {
        const int pos = pos0 + t4 * 16 + q4 * 4 + i;
        s[t4][i] = (pos >= tlo && pos <= thi) ? s[t4][i] : -1e30f;
      }
  }
  float mt = fmaxf(fmaxf(s[0][0], s[0][1]), fmaxf(s[0][2], s[0][3]));
#pragma unroll
  for (int t4 = 1; t4 < 4; ++t4) mt = fmaxf(mt, fmaxf(fmaxf(s[t4][0], s[t4][1]), fmaxf(s[t4][2], s[t4][3])));
  mt = fmaxf(mt, __shfl_xor(mt, 16));
  mt = fmaxf(mt, __shfl_xor(mt, 32));
  const float mn = active ? fmaxf(st.m, mt) : st.m;
  const float alpha = exp2f_(st.m - mn);
  float psum = 0.f;
#pragma unroll
  for (int t4 = 0; t4 < 4; ++t4)
#pragma unroll
    for (int i = 0; i < 4; ++i) {
      float pv = exp2f_(s[t4][i] - mn);
      if (MASKED) pv = s[t4][i] > -1e29f ? pv : 0.f;
      s[t4][i] = pv;
      psum += pv;
    }
  psum = active ? psum : 0.f;
  st.l = st.l * alpha + psum;
  st.m = mn;
#pragma unroll
  for (int dt = 0; dt < 4; ++dt) st.o[dt] *= alpha;
  const unsigned am = active ? 0xffffffffu : 0u;
#pragma unroll
  for (int a = 0; a < 2; ++a) {
    uint4 pu = __builtin_bit_cast(uint4, pack8(s[2 * a], s[2 * a + 1]));
    pu.x &= am;
    pu.y &= am;
    pu.z &= am;
    pu.w &= am;
    const bf16x8 pb = __builtin_bit_cast(bf16x8, pu);
#pragma unroll
    for (int dt = 0; dt < 4; ++dt) st.o[dt] = mfma16(f.v[a * 4 + dt], pb, st.o[dt]);
  }
}

struct KV8 {
  uint4 k[4];
  uint4 v[4];
};
DI long mk64(unsigned lo, unsigned hi) { return (long)(((unsigned long long)hi << 32) | (unsigned long long)lo); }
DI f32x4 mfma8(long a, long b, f32x4 c) { return __builtin_amdgcn_mfma_f32_16x16x32_fp8_fp8(a, b, c, 0, 0, 0); }
DI void load_kv8(KV8& f, const char* __restrict__ k8, const char* __restrict__ v8, int lane) {
#pragma unroll
  for (int p = 0; p < 4; ++p) f.k[p] = *(const uint4*)(k8 + (p * 64 + lane) * 16);
#pragma unroll
  for (int p = 0; p < 4; ++p) f.v[p] = *(const uint4*)(v8 + (p * 64 + lane) * 16);
}
template <bool MASKED>
DI void attn_compute8(SMState& st, const KV8& f, const long (&q8)[2], int pos0, int thi, bool active, int q4) {
  f32x4 s[4];
#pragma unroll
  for (int t4 = 0; t4 < 4; ++t4) {
    f32x4 z = {0.f, 0.f, 0.f, 0.f};
    z = mfma8(mk64(f.k[t4].x, f.k[t4].y), q8[0], z);
    z = mfma8(mk64(f.k[t4].z, f.k[t4].w), q8[1], z);
    s[t4] = z;
  }
  if (MASKED) {
#pragma unroll
    for (int t4 = 0; t4 < 4; ++t4)
#pragma unroll
      for (int i = 0; i < 4; ++i) {
        const int pos = pos0 + t4 * 16 + q4 * 4 + i;
        s[t4][i] = pos <= thi ? s[t4][i] : -1e30f;
      }
  }
  float mt = fmaxf(fmaxf(s[0][0], s[0][1]), fmaxf(s[0][2], s[0][3]));
#pragma unroll
  for (int t4 = 1; t4 < 4; ++t4) mt = fmaxf(mt, fmaxf(fmaxf(s[t4][0], s[t4][1]), fmaxf(s[t4][2], s[t4][3])));
  mt = fmaxf(mt, __shfl_xor(mt, 16));
  mt = fmaxf(mt, __shfl_xor(mt, 32));
  const float mn = active ? fmaxf(st.m, mt * 0.125f) : st.m;
  const float alpha = exp2f_(st.m - mn);
  const float eo = 8.f - mn;
  f32x4 ps4 = {0.f, 0.f, 0.f, 0.f};
#pragma unroll
  for (int t4 = 0; t4 < 4; ++t4) {
    const f32x4 ev = s[t4] * 0.125f + eo;
#pragma unroll
    for (int i = 0; i < 4; ++i) {
      float pv = exp2f_(ev[i]);
      if (MASKED) pv = s[t4][i] > -1e29f ? pv : 0.f;
      s[t4][i] = pv;
    }
    ps4 += s[t4];
  }
  float psum = (ps4[0] + ps4[1]) + (ps4[2] + ps4[3]);
  psum = active ? psum : 0.f;
  st.l = st.l * alpha + psum;
  st.m = mn;
#pragma unroll
  for (int dt = 0; dt < 4; ++dt) st.o[dt] *= alpha;
  const unsigned am = active ? 0xffffffffu : 0u;
#pragma unroll
  for (int a = 0; a < 2; ++a) {
    const unsigned p0 = cvt4_fp8(s[2 * a][0], s[2 * a][1], s[2 * a][2], s[2 * a][3]) & am;
    const unsigned p1 = cvt4_fp8(s[2 * a + 1][0], s[2 * a + 1][1], s[2 * a + 1][2], s[2 * a + 1][3]) & am;
    const long pb = mk64(p0, p1);
#pragma unroll
    for (int dt = 0; dt < 4; ++dt)
      st.o[dt] = mfma8(a == 0 ? mk64(f.v[dt].x, f.v[dt].y) : mk64(f.v[dt].z, f.v[dt].w), pb, st.o[dt]);
  }
}

template <bool MASKED>
DI void attn_pair8(SMState& st, const KV8& fa, const KV8& fb, const long (&q8)[2], int pos0, int thi, bool laneA, bool active,
                   bool useB, int q4) {
  f32x4 s[4];
  if (useB) {
    const long zq = 0;
    const long qa0 = laneA ? q8[0] : zq, qa1 = laneA ? q8[1] : zq;
    const long qb0 = laneA ? zq : q8[0], qb1 = laneA ? zq : q8[1];
#pragma unroll
    for (int t4 = 0; t4 < 4; ++t4) {
      f32x4 z = {0.f, 0.f, 0.f, 0.f};
      z = mfma8(mk64(fa.k[t4].x, fa.k[t4].y), qa0, z);
      z = mfma8(mk64(fa.k[t4].z, fa.k[t4].w), qa1, z);
      z = mfma8(mk64(fb.k[t4].x, fb.k[t4].y), qb0, z);
      z = mfma8(mk64(fb.k[t4].z, fb.k[t4].w), qb1, z);
      s[t4] = z;
    }
  } else {
#pragma unroll
    for (int t4 = 0; t4 < 4; ++t4) {
      f32x4 z = {0.f, 0.f, 0.f, 0.f};
      z = mfma8(mk64(fa.k[t4].x, fa.k[t4].y), q8[0], z);
      z = mfma8(mk64(fa.k[t4].z, fa.k[t4].w), q8[1], z);
      s[t4] = z;
    }
  }
#pragma unroll
  for (int t4 = 0; t4 < 4; ++t4) s[t4] = s[t4] * 0.125f;
  if (MASKED) {
#pragma unroll
    for (int t4 = 0; t4 < 4; ++t4)
#pragma unroll
      for (int i = 0; i < 4; ++i) {
        const int pos = pos0 + t4 * 16 + q4 * 4 + i;
        s[t4][i] = pos <= thi ? s[t4][i] : -1e30f;
      }
  }
  float mt = fmaxf(fmaxf(s[0][0], s[0][1]), fmaxf(s[0][2], s[0][3]));
#pragma unroll
  for (int t4 = 1; t4 < 4; ++t4) mt = fmaxf(mt, fmaxf(fmaxf(s[t4][0], s[t4][1]), fmaxf(s[t4][2], s[t4][3])));
  mt = fmaxf(mt, __shfl_xor(mt, 16));
  mt = fmaxf(mt, __shfl_xor(mt, 32));
  const float mn = active ? fmaxf(st.m, mt) : st.m;
  const float alpha = exp2f_(st.m - mn);
  const float eo = 8.f - mn;
  f32x4 ps4 = {0.f, 0.f, 0.f, 0.f};
#pragma unroll
  for (int t4 = 0; t4 < 4; ++t4) {
    const f32x4 ev = s[t4] + eo;
#pragma unroll
    for (int i = 0; i < 4; ++i) {
      float pv = exp2f_(ev[i]);
      if (MASKED) pv = s[t4][i] > -1e29f ? pv : 0.f;
      s[t4][i] = pv;
    }
    ps4 += s[t4];
  }
  float psum = (ps4[0] + ps4[1]) + (ps4[2] + ps4[3]);
  psum = active ? psum : 0.f;
  st.l = st.l * alpha + psum;
  st.m = mn;
#pragma unroll
  for (int dt = 0; dt < 4; ++dt) st.o[dt] *= alpha;
  const unsigned amA = (active && laneA) ? 0xffffffffu : 0u;
  const unsigned amB = (active && !laneA) ? 0xffffffffu : 0u;
#pragma unroll
  for (int a = 0; a < 2; ++a) {
    const unsigned p0 = cvt4_fp8(s[2 * a][0], s[2 * a][1], s[2 * a][2], s[2 * a][3]);
    const unsigned p1 = cvt4_fp8(s[2 * a + 1][0], s[2 * a + 1][1], s[2 * a + 1][2], s[2 * a + 1][3]);
    const long pbA = mk64(p0 & amA, p1 & amA);
#pragma unroll
    for (int dt = 0; dt < 4; ++dt)
      st.o[dt] = mfma8(a == 0 ? mk64(fa.v[dt].x, fa.v[dt].y) : mk64(fa.v[dt].z, fa.v[dt].w), pbA, st.o[dt]);
    if (useB) {
      const long pbB = mk64(p0 & amB, p1 & amB);
#pragma unroll
      for (int dt = 0; dt < 4; ++dt)
        st.o[dt] = mfma8(a == 0 ? mk64(fb.v[dt].x, fb.v[dt].y) : mk64(fb.v[dt].z, fb.v[dt].w), pbB, st.o[dt]);
    }
  }
}

DI void sm_init(SMState& st) {
  st.m = -1e30f;
  st.l = 0.f;
#pragma unroll
  for (int dt = 0; dt < 4; ++dt) st.o[dt] = f32x4{0.f, 0.f, 0.f, 0.f};
}
DI float sm_invl(const SMState& st) {
  float L = st.l + __shfl_xor(st.l, 16);
  L += __shfl_xor(L, 32);
  return L > 0.f ? 1.f / L : 0.f;
}

DI void hg_scan(const int tid, const float* __restrict__ logf, int row0, int h, float* segs  , float (&lf)[16], float (&bb)[16],
                float& total) {
  const int k = tid & 127, seg = tid >> 7;
  float run = 0.f;
#pragma unroll
  for (int i = 0; i < 16; ++i) {
    lf[i] = logf[(size_t)(row0 + seg * 16 + i) * 1024 + h * 128 + k];
    run += lf[i];
    bb[i] = run;
  }
  segs[seg * 128 + k] = run;
  __syncthreads();
  float off = 0.f, tot = 0.f;
#pragma unroll
  for (int s2 = 0; s2 < 4; ++s2) {
    const float v = segs[s2 * 128 + k];
    if (s2 < seg) off += v;
    tot += v;
  }
#pragma unroll
  for (int i = 0; i < 16; ++i) bb[i] += off;
  total = tot;
}

#define wt_nsa_in ((u16*)(p.ws + OFF_WT_NSA_IN))
#define wt_hg_in ((u16*)(p.ws + OFF_WT_HG_IN))
#define wt_nsa_out ((u16*)(p.ws + OFF_WT_NSA_OUT))
#define wt_hg_out ((u16*)(p.ws + OFF_WT_HG_OUT))
#define wt_k1 ((u16*)(p.ws + OFF_WT_K1))
#define wt_v1 ((u16*)(p.ws + OFF_WT_V1))
#define rope ((float2*)(p.ws + OFF_ROPE))
#define bias1 ((float*)(p.ws + OFF_MISC))
#define lbv ((float*)(p.ws + OFF_MISC) + 512)
#define Hb ((u16*)(p.ws + OFF_H))
#define Qb ((u16*)(p.ws + OFF_Q))
#define KCb ((u16*)(p.ws + OFF_KC))
#define VCb ((u16*)(p.ws + OFF_VC))
#define KSb ((u16*)(p.ws + OFF_KS))
#define VSTb ((u16*)(p.ws + OFF_VST))
#define KWb ((u16*)(p.ws + OFF_KW))
#define VWTb ((u16*)(p.ws + OFF_VWT))
#define SZb ((u16*)(p.ws + OFF_SZ))
#define GATESb ((float*)(p.ws + OFF_GATES))
#define HIDb ((u16*)(p.ws + OFF_HID))
#define KCMPb ((u16*)(p.ws + OFF_KCMP))
#define VCMPTb ((u16*)(p.ws + OFF_VCMPT))
#define Ob ((u16*)(p.ws + OFF_O))
#define STb ((u16*)(p.ws + OFF_STATES))
#define QHb ((u16*)(p.ws + OFF_QH))
#define LOGFb ((float*)(p.ws + OFF_LOGF))
#define VHb ((u16*)(p.ws + OFF_VH))
#define SZHb ((u16*)(p.ws + OFF_SZH))
#define DCb ((float*)(p.ws + OFF_DC))

#define XB_TMO      128
#define XB_XCNT(j)  (256  + 64 * (j))
#define XB_XSUB(j)  (1280 + 64 * (j))
#define XB_XGEN(j)  (2304 + 64 * (j))
#define XB_TOP      3328
#define XB_TOPGEN   3392
#define XCD_BAR_WORDS 3456
#define XB_SPIN_CAP (1u << 18)
#define LAS __attribute__((address_space(3)))

__device__ __forceinline__ unsigned xb_ld(unsigned* p)              { return __hip_atomic_load(p, __ATOMIC_RELAXED, __HIP_MEMORY_SCOPE_AGENT); }
__device__ __forceinline__ unsigned xb_add(unsigned* p, unsigned v) { return __hip_atomic_fetch_add(p, v, __ATOMIC_RELAXED, __HIP_MEMORY_SCOPE_AGENT); }
__device__ __forceinline__ unsigned xb_xcc_id() { return (unsigned)__builtin_amdgcn_s_getreg((3 << 11) | 20) & 0xFu; }
#define XB_SPIN(cond, bar) do { unsigned _sp = 0; while (cond) { __builtin_amdgcn_s_sleep(1); \
    if ((++_sp & 255u) == 0u) { if (xb_ld(&(bar)[XB_TMO])) break; if (_sp > XB_SPIN_CAP) { atomicAdd(&(bar)[XB_TMO], 1u); break; } } } } while (0)

struct XcdBarrier {
    unsigned* bar; unsigned x;
    volatile LAS unsigned* st;
};

__device__ __forceinline__ XcdBarrier xcd_barrier_post(unsigned* bar, volatile LAS unsigned* st) {
    XcdBarrier b; b.bar = bar; b.x = xb_xcc_id(); b.st = st;
    if (threadIdx.x == 0) (void)xb_add(&bar[XB_XCNT(b.x)], 1u);
    return b;
}
__device__ __forceinline__ void xcd_barrier_complete(unsigned* bar, unsigned x, unsigned& nloc, unsigned& nx) {
    const unsigned G = gridDim.x * gridDim.y * gridDim.z;
    unsigned sum, cnt, mine, sp = 0u;
    for (;;) {
        sum = 0u; cnt = 0u; mine = 0u;
#pragma unroll
        for (unsigned j = 0; j < 16; ++j) { const unsigned c = xb_ld(&bar[XB_XCNT(j)]); sum += c; cnt += (c > 0u) ? 1u : 0u; mine = (j == x) ? c : mine; }
        if (sum == G) break;
        __builtin_amdgcn_s_sleep(1);
        if ((++sp & 255u) == 0u) { if (xb_ld(&bar[XB_TMO])) break; if (sp > XB_SPIN_CAP) { atomicAdd(&bar[XB_TMO], 1u); break; } }
    }
    nloc = mine > 0u ? mine : 1u; nx = cnt > 0u ? cnt : 1u;
}

__device__ __forceinline__ void xcd_barrier(const XcdBarrier& b) {
    asm volatile("s_waitcnt vmcnt(0)" ::: "memory");
    __syncthreads();
    if (threadIdx.x == 0) {
        unsigned* bar = b.bar;
        __builtin_amdgcn_s_waitcnt(0);
        unsigned nloc = b.st[0], nx = b.st[1];
        if (nloc == 0u) { xcd_barrier_complete(bar, b.x, nloc, nx); b.st[0] = nloc; b.st[1] = nx; }
        const unsigned old = xb_add(&bar[XB_XSUB(b.x)], 1u);
        const unsigned gen = old / nloc;
        if (old + 1u == (gen + 1u) * nloc) {
            __builtin_amdgcn_fence(__ATOMIC_RELEASE, "agent");
            asm volatile("s_waitcnt vmcnt(0)" ::: "memory");
            const unsigned og = xb_add(&bar[XB_TOP], 1u);
            const unsigned tg = og / nx;
            if (og + 1u == (tg + 1u) * nx) xb_add(&bar[XB_TOPGEN], 1u);
            else XB_SPIN(xb_ld(&bar[XB_TOPGEN]) == tg, bar);
            __builtin_amdgcn_fence(__ATOMIC_ACQUIRE, "agent");
            xb_add(&bar[XB_XGEN(b.x)], 1u);
            asm volatile("s_waitcnt vmcnt(0)" ::: "memory");
        } else {
            XB_SPIN(xb_ld(&bar[XB_XGEN(b.x)]) == gen, bar);
            __builtin_amdgcn_fence(__ATOMIC_ACQUIRE, "agent");
            asm volatile("s_waitcnt vmcnt(0)" ::: "memory");
        }
    }
    __syncthreads();
}


DI void gbar(unsigned* ctr, unsigned target) {
  asm volatile("s_waitcnt vmcnt(0) lgkmcnt(0)" ::: "memory");
  __syncthreads();
  if (threadIdx.x == 0) {
    __builtin_amdgcn_fence(__ATOMIC_RELEASE, "agent");
    asm volatile("s_waitcnt vmcnt(0)" ::: "memory");
    __hip_atomic_fetch_add(ctr, 1u, __ATOMIC_RELAXED, __HIP_MEMORY_SCOPE_AGENT);
    while (__hip_atomic_load(ctr, __ATOMIC_RELAXED, __HIP_MEMORY_SCOPE_AGENT) < target) __builtin_amdgcn_s_sleep(2);
  }
  __syncthreads();
  __builtin_amdgcn_fence(__ATOMIC_ACQUIRE, "agent");
  asm volatile("s_waitcnt vmcnt(0)" ::: "memory");
}

#define FOR_TILES_XCD(NT_, MT_VAR, NT_VAR)                                                                   \
  for (int lt_ = ((gridDim.x & 7) == 0 ? (int)(blockIdx.x >> 3) : (int)blockIdx.x), MT_VAR = 0, NT_VAR = 0; \
       lt_ < ((gridDim.x & 7) == 0 ? 16 * (NT_) : 128 * (NT_)) &&                                           \
       (MT_VAR = ((gridDim.x & 7) == 0 ? (int)(blockIdx.x & 7) * 16 : 0) + lt_ / (NT_), NT_VAR = lt_ % (NT_), true); \
       lt_ += ((gridDim.x & 7) == 0 ? (int)(gridDim.x >> 3) : (int)gridDim.x))

__global__ void __launch_bounds__(NTHR) mega(Params p) {
  char* const smem = dyn_lds;
  cg::grid_group grid = cg::this_grid();
  int tid, lane, wave, gw, gt;
  const int nw = gridDim.x * (NTHR / 64), ngt = gridDim.x * NTHR;
#define REFRESH()                                  \
  {                                                \
    tid = threadIdx.x;                             \
    asm volatile("" : "+v"(tid));                  \
    lane = tid & 63;                               \
    wave = tid >> 6;                               \
    gw = blockIdx.x * (NTHR / 64) + wave;          \
    gt = blockIdx.x * NTHR + tid;                  \
  }
  unsigned* bar_ctr = (unsigned*)(p.ws + OFF_MISC + 16384);
  __shared__ uint4 xb_words;
  if (threadIdx.x == 0) xb_words = make_uint4(0u, 0u, 0u, 0u);
  __syncthreads();
  const XcdBarrier xb = xcd_barrier_post(bar_ctr, (volatile LAS unsigned*)&xb_words);
  REFRESH();

  PH(0) {
  REFRESH();
  transpose_w(smem, tid, p.nsa_w_in, 3632, wt_nsa_in, 1024, NSA_NP, [](int n) {
    return n < 2560 ? n : (n < 3584 ? n + 48 : (n < 3632 ? n - 1024 : -1));
  });
  transpose_w(smem, tid, p.hg_w_in, 4096, wt_hg_in, 1024, 4096, [](int n) { return n; });
  transpose_w(smem, tid, p.nsa_w_out, 1024, wt_nsa_out, 1024, 1024, [](int n) { return n; });
  transpose_w(smem, tid, p.hg_w_out, 1024, wt_hg_out, 1024, 1024, [](int n) { return n; });
  transpose_w(smem, tid, p.wk1, 256, wt_k1, 2048, 256, [](int n) { return n; });
  transpose_w(smem, tid, p.wv1, 256, wt_v1, 2048, 256, [](int n) { return n; });
  for (int e = gt; e < SEQ * 32; e += ngt) {
    const int pos = e >> 5, d = e & 31;
    double inv = 1.0;
    for (int i = 0; i < d; ++i) inv *= 0.7498942093324559;
    const float invf = (float)inv;
    const float ang = (float)pos * invf;
    float cs, sn;
    sincos_reduced((double)ang, cs, sn);
    rope[e] = make_float2(cs, sn);
  }
  for (int o = gw; o < 512; o += nw) {
    const int which = o >> 8, j = o & 255;
    const float* pe = which ? p.pe_v : p.pe_k;
    const float* w1 = which ? p.wv1 : p.wk1;
    float acc = 0.f;
    for (int k = lane; k < 2048; k += 64) acc += pe[k] * w1[(size_t)k * 256 + j];
    acc = wave_sum(acc);
    if (lane == 0) bias1[o] = acc;
  }
  for (int k = gt; k < 1024; k += ngt) {
    const float l0 = p.lb_logits[k], l1 = p.lb_logits[1024 + k];
    const float mx = fmaxf(l0, l1);
    const float e0 = __expf(l0 - mx), e1 = __expf(l1 - mx);
    const float p0 = e0 / (e0 + e1), p1 = e1 / (e0 + e1);
    lbv[k] = (p0 + p1) - p0;
  }
  rmsnorm_to_bf16(p.x, p.norm_w, Hb, gw, nw, lane);
  }
  if (p.ws == nullptr) grid.sync();
  xcd_barrier(xb);

  PH(1) {
  REFRESH();
  {
    auto afn = [&](int row, int k) { return Hb + (size_t)row * 1024 + k; };
    const int lane_ = lane;
    auto epi = [&](f32x16(&accf)[2][4], int mb, int nb, auto nio_) {
      constexpr int NIO = decltype(nio_)::value;
      int lane = lane_;
      asm volatile("" : "+v"(lane));
      const int l31 = lane & 31, lh = lane >> 5;
      const int b = mb >> 14;
      char* wlds = smem + wave * 8192;
      const bool is_q = nb < 1024;
      const bool is_ks = nb >= 1536 && nb < 1792;
      const bool is_kw = nb >= 2048 && nb < 2304;
      if (is_q || is_ks || is_kw) {
        const float scale = is_q ? 0.18033688011112042f : 1.f;
        const float2* ropep = rope + ((mb & (SEQ - 1)) + lh * 4) * 32 + l31;
        auto vf = [&](int mi, int i) {
          const float2 cs = ropep[(mi * 32 + (i >> 2) * 8 + (i & 3)) * 32];
          const float x1 = accf[mi][NIO + 0][i], x2 = accf[mi][NIO + 1][i];
          return F2{(x1 * cs.x - x2 * cs.y) * scale, (x2 * cs.x + x1 * cs.y) * scale};
        };
        if (is_q) {
          stage_out<0>(wlds, lane, vf, Qb + (size_t)mb * 1024 + nb, 1024);
        } else {
          const int g = ((nb - (is_ks ? 1536 : 2048)) >> 6);
          const int blk = (mb & (SEQ - 1)) >> 6;
          if (is_ks) stage_out<1, true>(wlds, lane, vf, (u16*)((char*)KSb + ((size_t)(b * 4 + g) * 256 + blk) * 4096), 0);
          else stage_out<1>(wlds, lane, vf, KWb + ((size_t)(b * 4 + g) * 256 + blk) * 4096, 0);
        }
      } else if (nb >= 1024 && nb < 1536) {
        auto vf = [&](int mi, int i) { return F2{accf[mi][NIO + 0][i], accf[mi][NIO + 1][i]}; };
        stage_out<0>(wlds, lane, vf, (nb < 1280 ? KCb : VCb) + (size_t)mb * 256 + (nb & 255), 256);
      } else if ((nb >= 1792 && nb < 2048) || (nb >= 2304 && nb < 2560)) {
        const bool is_vs = nb < 2048;
        const int g = (nb - (is_vs ? 1792 : 2304)) >> 6;
        const int blk = (mb & (SEQ - 1)) >> 6;
        auto vf = [&](int mi, int i) { return F2{accf[mi][NIO + 0][i], accf[mi][NIO + 1][i]}; };
        if (is_vs) stage_out<2, true>(wlds, lane, vf, (u16*)((char*)VSTb + ((size_t)((b * 4 + g) * 256 + blk)) * 4096), 0);
        else stage_out<2>(wlds, lane, vf, VWTb + ((size_t)((b * 4 + g) * 256 + blk)) * 4096, 0);
      } else if (nb >= 2560 && nb < 3584) {
        auto vf = [&](int mi, int i) { return F2{siluf_(accf[mi][NIO + 0][i]), siluf_(accf[mi][NIO + 1][i])}; };
        stage_out<0>(wlds, lane, vf, SZb + (size_t)mb * 1024 + (nb - 2560), 1024);
      } else {
#pragma unroll
        for (int mi = 0; mi < 2; ++mi)
#pragma unroll
          for (int ni = 0; ni < 2; ++ni) {
            const int col = nb - 3584 + ni * 32 + l31;
            if (col < 48) {
#pragma unroll
              for (int i = 0; i < 16; ++i) {
                const int row = mb + mi * 32 + (i >> 2) * 8 + lh * 4 + (i & 3);
                GATESb[(size_t)row * 48 + col] = sigmoidf_(accf[mi][NIO + ni][i]);
              }
            }
          }
      }
    };
    const int NNT = NSA_NP / 256;
    FOR_TILES_XCD(NNT, mt, nt) gemm_tile256(smem, tid, afn, wt_nsa_in, 1024, mt * 256, nt * 256, epi);
  }
  }
  xcd_barrier(xb);

  PH(2) {
  REFRESH();
  {
    for (int t = blockIdx.x; t < 64; t += gridDim.x) {
      const int which = t >> 5, mt = t & 31;
      const u16* src = which ? VCb : KCb;
      auto afn = [&](int row, int k) {
        const int b = row >> 12, g = (row >> 10) & 3;
        int n = row & 1023;
        n = n > 1022 ? 1022 : n;
        return src + (size_t)(b * SEQ + 16 * n + (k >> 6)) * 256 + g * 64 + (k & 63);
      };
      const int lane_ = lane;
    auto epi = [&](f32x16(&accf)[2][4], int mb, int nb, auto nio_) {
        constexpr int NIO = decltype(nio_)::value;
        int lane = lane_;
        asm volatile("" : "+v"(lane));
        const int l31 = lane & 31;
        const float b0 = bias1[which * 256 + nb + l31], b1 = bias1[which * 256 + nb + 32 + l31];
        auto vf = [&](int mi, int i) { return F2{siluf_(accf[mi][NIO + 0][i] + b0), siluf_(accf[mi][NIO + 1][i] + b1)}; };
        stage_out<0>(smem + wave * 8192, lane, vf, HIDb + ((size_t)which * 8192 + mb) * 256 + nb, 256);
      };
      gemm_tile256(smem, tid, afn, which ? wt_v1 : wt_k1, 2048, mt * 256, 0, epi);
    }
  }
  }
  xcd_barrier(xb);

  PH(3) {
  REFRESH();
  float* w2k = (float*)smem;
  float* w2v = (float*)(smem + 65536);
  for (int i = tid; i < 4096; i += NTHR) {
    ((float4*)w2k)[i] = ((const float4*)p.wk2)[i];
    ((float4*)w2v)[i] = ((const float4*)p.wv2)[i];
  }
  __syncthreads();
  for (int e = gt; e < 8192 * 32; e += ngt) {
    const int m = e >> 5, d = e & 31;
    float k1 = 0.f, k2 = 0.f, v1 = 0.f, v2 = 0.f;
    const u16* hk = HIDb + (size_t)m * 256;
    const u16* hv = HIDb + ((size_t)8192 + m) * 256;
    for (int j0 = 0; j0 < 256; j0 += 8) {
      const uint4 uk = *(const uint4*)(hk + j0);
      const uint4 uv = *(const uint4*)(hv + j0);
      const unsigned ak[4] = {uk.x, uk.y, uk.z, uk.w};
      const unsigned av[4] = {uv.x, uv.y, uv.z, uv.w};
#pragma unroll
      for (int jj = 0; jj < 8; ++jj) {
        const float fk = (jj & 1) ? bfhi(ak[jj >> 1]) : bflo(ak[jj >> 1]);
        const float fv = (jj & 1) ? bfhi(av[jj >> 1]) : bflo(av[jj >> 1]);
        const int j = j0 + jj;
        k1 += fk * w2k[j * 64 + d];
        k2 += fk * w2k[j * 64 + 32 + d];
        v1 += fv * w2v[j * 64 + d];
        v2 += fv * w2v[j * 64 + 32 + d];
      }
    }
    const int n = m & 1023, bg = m >> 10;
    int pos = 16 * n + 31;
    pos = pos > SEQ - 1 ? SEQ - 1 : pos;
    const float2 cs = rope[pos * 32 + d];
    u16* kt_ = KCMPb + (size_t)(bg * 16 + (n >> 6)) * 4096;
    kt_[kfrag_off(n & 63, d)] = f2bf(k1 * cs.x - k2 * cs.y);
    kt_[kfrag_off(n & 63, 32 + d)] = f2bf(k2 * cs.x + k1 * cs.y);
    u16* vt = VCMPTb + (size_t)(bg * 16 + (n >> 6)) * 4096;
    vt[vfrag_off(d, n & 63)] = f2bf(v1);
    vt[vfrag_off(d + 32, n & 63)] = f2bf(v2);
  }
  }
  xcd_barrier(xb);

  PH(4) {
  REFRESH();
  {
    const int c = lane & 15, q4 = lane >> 4, tokc = c >> 2, r = c & 3;
    float* imp = (float*)(smem + wave * 6144);
    unsigned* keys_l = (unsigned*)(smem + wave * 6144 + 4096);
    int* sel_l = (int*)(smem + wave * 6144 + 5120);
    const int ngrp = gridDim.x < 8 ? gridDim.x : 8;
    const int grp = blockIdx.x % ngrp, lb = blockIdx.x / ngrp;
    const int nbg = (gridDim.x - grp + ngrp - 1) / ngrp;
    for (int bg = grp; bg < 8; bg += ngrp)
    for (int t4 = lb * (NTHR / 64) + wave; t4 < 4096; t4 += nbg * (NTHR / 64)) {
      const int b = bg >> 2, g = bg & 3;
      const int tok0 = t4 * 4, t_c = tok0 + tokc, head = g * 4 + r;
      const size_t trow = (size_t)(b * SEQ + t_c);
      bf16x8 qf[2];
      {
        const u16* qp = Qb + trow * 1024 + head * 64 + q4 * 8;
        qf[0] = ld8(qp);
        qf[1] = ld8(qp + 32);
      }
      KVFrag fa, fb;
      f32x4 oc[4];
      {
        const int nmax_c = (t_c >= 31) ? ((t_c - 31) >> 4) : -1;
        const int nmax_w = (tok0 + 3 >= 31) ? ((tok0 + 3 - 31) >> 4) : -1;
        const int nkt = (nmax_w >= 0) ? (nmax_w >> 6) + 1 : 0;
        const u16* kcb = KCMPb + (size_t)bg * 1024 * 64;
        const u16* vcb = VCMPTb + (size_t)bg * 16 * 4096;
        float m_l = -1e30f, l_l = 0.f;
        const int nmax_0 = (tok0 >= 31) ? ((tok0 - 31) >> 4) : -1;
        auto pass1 = [&](const KVFrag& f, int kt) {
          f32x4 s[4];
          qk_scores(s, f, qf);
          const bool full = kt * 64 + 63 <= nmax_0;
          if (!full) {
#pragma unroll
            for (int st = 0; st < 4; ++st)
#pragma unroll
              for (int i = 0; i < 4; ++i) {
                const int n = kt * 64 + st * 16 + q4 * 4 + i;
                s[st][i] = n <= nmax_c ? s[st][i] : -1e30f;
              }
          }
          float mt = -1e30f;
#pragma unroll
          for (int st = 0; st < 4; ++st) mt = fmaxf(mt, fmaxf(fmaxf(s[st][0], s[st][1]), fmaxf(s[st][2], s[st][3])));
          const float mn = fmaxf(m_l, mt);
          float a = 0.f;
          if (full) {
#pragma unroll
            for (int st = 0; st < 4; ++st)
#pragma unroll
              for (int i = 0; i < 4; ++i) a += exp2f_(s[st][i] - mn);
          } else {
#pragma unroll
            for (int st = 0; st < 4; ++st)
#pragma unroll
              for (int i = 0; i < 4; ++i) a += s[st][i] > -1e29f ? exp2f_(s[st][i] - mn) : 0.f;
          }
          l_l = l_l * exp2f_(m_l - mn) + a;
          m_l = mn;
        };
        if (nkt > 0) {
          load_k(fa, kcb, c, q4);
#pragma unroll 1
          for (int kt = 0; kt < nkt; kt += 2) {
            const int k1 = kt + 1 < nkt ? kt + 1 : nkt - 1;
            load_k(fb, kcb + k1 * 4096, c, q4);
            pass1(fa, kt);
            const int k2 = kt + 2 < nkt ? kt + 2 : nkt - 1;
            load_k(fa, kcb + k2 * 4096, c, q4);
            if (kt + 1 < nkt) pass1(fb, kt + 1);
          }
        }
        float M = fmaxf(m_l, __shfl_xor(m_l, 16));
        M = fmaxf(M, __shfl_xor(M, 32));
        const float lsc = l_l * exp2f_(m_l - M);
        float L = lsc + __shfl_xor(lsc, 16);
        L += __shfl_xor(L, 32);
        const float ML = L > 0.f ? M + __log2f(L) : 1e30f;
#pragma unroll
        for (int i = 0; i < 16; ++i) imp[lane + 64 * i] = 0.f;
#pragma unroll
        for (int dt = 0; dt < 4; ++dt) oc[dt] = f32x4{0.f, 0.f, 0.f, 0.f};
        auto pass2 = [&](const KVFrag& f, int kt) {
          bf16x8 vv[8];
          {
            const u16* vp = vcb + kt * 4096 + (q4 * 16 + c) * 8;
#pragma unroll
            for (int fr = 0; fr < 8; ++fr) vv[fr] = ld8(vp + fr * 512);
          }
          f32x4 s[4];
          qk_scores(s, f, qf);
          const bool full2 = kt * 64 + 63 <= nmax_0;
#pragma unroll
          for (int st = 0; st < 4; ++st) {
            if (full2) {
#pragma unroll
              for (int i = 0; i < 4; ++i) s[st][i] = exp2f_(s[st][i] - ML);
            } else {
#pragma unroll
              for (int i = 0; i < 4; ++i) {
                const int n = kt * 64 + st * 16 + q4 * 4 + i;
                s[st][i] = n <= nmax_c ? exp2f_(s[st][i] - ML) : 0.f;
              }
            }
            float s4 = (s[st][0] + s[st][1]) + (s[st][2] + s[st][3]);
            float lst = s[st][3];
            s4 += dpp_xor1(s4);
            s4 += dpp_xor2(s4);
            lst += dpp_xor1(lst);
            lst += dpp_xor2(lst);
            const int j = kt * 16 + st * 4 + q4;
            if (r == 0) {
              atomicAdd(&imp[tokc * 256 + j], s4);
              if (j + 1 < 256) atomicAdd(&imp[tokc * 256 + j + 1], lst);
            }
          }
#pragma unroll
          for (int a = 0; a < 2; ++a) {
            const bf16x8 pb = pack8(s[2 * a], s[2 * a + 1]);
#pragma unroll
            for (int dt = 0; dt < 4; ++dt) oc[dt] = mfma16(vv[a * 4 + dt], pb, oc[dt]);
          }
        };
        if (nkt > 0) {
          load_k(fa, kcb, c, q4);
#pragma unroll 1
          for (int kt = 0; kt < nkt; kt += 2) {
            const int k1 = kt + 1 < nkt ? kt + 1 : nkt - 1;
            load_k(fb, kcb + k1 * 4096, c, q4);
            pass2(fa, kt);
            const int k2 = kt + 2 < nkt ? kt + 2 : nkt - 1;
            load_k(fa, kcb + k2 * 4096, c, q4);
            if (kt + 1 < nkt) pass2(fb, kt + 1);
          }
        }
        const float g0 = GATESb[trow * 48 + head * 3 + 0];
#pragma unroll
        for (int dt = 0; dt < 4; ++dt) oc[dt] *= g0;
      }
      __builtin_amdgcn_wave_barrier();
      {
        const int cur = tok0 >> 6;
        unsigned my[4][4];
#pragma unroll
        for (int tk = 0; tk < 4; ++tk)
#pragma unroll
          for (int cc = 0; cc < 4; ++cc) {
            const int j = lane + 64 * cc;
            const bool forced = (j == 0) || (j == cur) || (j == cur - 1);
            const unsigned fb_ = __float_as_uint(imp[tk * 256 + j]) & 0xffffff00u;
            my[tk][cc] = (forced ? 0xffffff00u : (j <= cur ? fb_ : 0u)) | (unsigned)(255 - j);
          }
        unsigned T[4] = {0u, 0u, 0u, 0u};
#pragma unroll 1
        for (int bit = 31; bit >= 0; --bit) {
#pragma unroll
          for (int tk = 0; tk < 4; ++tk) {
            const unsigned cand = T[tk] | (1u << bit);
            const int n_ge = __popcll(__ballot(my[tk][0] >= cand)) + __popcll(__ballot(my[tk][1] >= cand)) +
                             __popcll(__ballot(my[tk][2] >= cand)) + __popcll(__ballot(my[tk][3] >= cand));
            T[tk] = n_ge >= 16 ? cand : T[tk];
          }
        }
#pragma unroll
        for (int tk = 0; tk < 4; ++tk) {
          int base = 0;
#pragma unroll
          for (int cc = 0; cc < 4; ++cc) {
            const int jq = lane + 64 * cc;
            const bool selq = my[tk][cc] >= T[tk] && !((jq == 0) || (jq == cur) || (jq == cur - 1));
            const unsigned long long mask = __ballot(selq);
            const int pos = base + __popcll(mask & ((1ull << lane) - 1ull));
            if (selq) sel_l[tk * 16 + pos] = lane + 64 * cc;
            base += __popcll(mask);
          }
        }
        __builtin_amdgcn_wave_barrier();
      }
      float* stash = imp;
#pragma unroll
      for (int dt = 0; dt < 4; ++dt)
#pragma unroll
        for (int i = 0; i < 4; ++i) stash[(dt * 4 + i) * 64 + lane] = oc[dt][i];
      {
        SMState ss;
        sm_init(ss);
        long q8[2];
#pragma unroll
        for (int ks = 0; ks < 2; ++ks) {
          const uint4 u = __builtin_bit_cast(uint4, qf[ks]);
          const unsigned lo = cvt4_fp8(bflo(u.x) * 8.f, bfhi(u.x) * 8.f, bflo(u.y) * 8.f, bfhi(u.y) * 8.f);
          const unsigned hi = cvt4_fp8(bflo(u.z) * 8.f, bfhi(u.z) * 8.f, bflo(u.w) * 8.f, bfhi(u.w) * 8.f);
          q8[ks] = mk64(lo, hi);
        }
        const char* ksb = (const char*)KSb + (size_t)bg * 256 * 4096;
        const char* vsb = (const char*)VSTb + (size_t)bg * 256 * 4096;
        const int curw = tok0 >> 6;
        const int nf = curw >= 2 ? 3 : curw + 1;
        const int len = 16 - nf;
        const int total = nf + 2 * len;
        auto entry = [&](int x, int& blkB, int& pp) {
          x = x < total ? x : total - 1;
          if (x < nf) {
            pp = -1;
            const int fb_ = x == 0 ? 0 : (x == nf - 1 ? curw : curw - 1);
            blkB = fb_;
            return fb_;
          }
          const int e = x - nf;
          pp = e / len;
          const int it = e - pp * len;
          blkB = __builtin_amdgcn_readfirstlane(sel_l[(2 * pp + 1) * 16 + it]);
          return __builtin_amdgcn_readfirstlane(sel_l[(2 * pp) * 16 + it]);
        };
        auto visit = [&](const KV8& fa_, const KV8& fb_, int blkA, int blkB, int pp) {
          if (pp < 0) {
            if (blkA < curw) attn_pair8<false>(ss, fa_, fb_, q8, blkA * 64, t_c, true, true, false, q4);
            else attn_pair8<true>(ss, fa_, fb_, q8, blkA * 64, t_c, true, true, false, q4);
          } else {
            const bool laneA = tokc == 2 * pp;
            const bool act = (laneA && blkA < curw) || (tokc == 2 * pp + 1 && blkB < curw);
            attn_pair8<false>(ss, fa_, fb_, q8, 0, t_c, laneA, act, true, q4);
          }
        };
        KV8 ga0, gb0, ga1, gb1;
        int pA0, pB0, pp0, pA1, pB1, pp1;
        pA0 = entry(0, pB0, pp0);
        load_kv8(ga0, ksb + pA0 * 4096, vsb + pA0 * 4096, lane);
        load_kv8(gb0, ksb + pB0 * 4096, vsb + pB0 * 4096, lane);
#pragma unroll 1
        for (int x = 0; x < total; x += 2) {
          pA1 = entry(x + 1, pB1, pp1);
          load_kv8(ga1, ksb + pA1 * 4096, vsb + pA1 * 4096, lane);
          load_kv8(gb1, ksb + pB1 * 4096, vsb + pB1 * 4096, lane);
          visit(ga0, gb0, pA0, pB0, pp0);
          pA0 = entry(x + 2, pB0, pp0);
          load_kv8(ga0, ksb + pA0 * 4096, vsb + pA0 * 4096, lane);
          load_kv8(gb0, ksb + pB0 * 4096, vsb + pB0 * 4096, lane);
          if (x + 1 < total) visit(ga1, gb1, pA1, pB1, pp1);
        }
        const float inv = sm_invl(ss) * GATESb[trow * 48 + head * 3 + 1];
#pragma unroll
        for (int dt = 0; dt < 4; ++dt)
#pragma unroll
          for (int i = 0; i < 4; ++i) stash[(dt * 4 + i) * 64 + lane] += ss.o[dt][i] * inv;
      }
      {
        {
          const u16* qp = Qb + trow * 1024 + head * 64 + q4 * 8;
          qf[0] = ld8(qp);
          qf[1] = ld8(qp + 32);
          asm volatile("" : "+v"(qf[0]), "+v"(qf[1]));
        }
        SMState sw;
        sm_init(sw);
        const u16* kwb = KWb + (size_t)bg * SEQ * 64;
        const u16* vwb = VWTb + (size_t)bg * 256 * 4096;
        const int lo = tok0 - 511 > 0 ? tok0 - 511 : 0;
        const int kt0 = lo >> 6, kt1 = (tok0 + 3) >> 6;
        load_k(fa, kwb + kt0 * 4096, c, q4);
        load_v(fa, vwb + kt0 * 4096, c, q4);
#pragma unroll 1
        for (int kt = kt0; kt <= kt1; kt += 2) {
          const int k1 = kt + 1 <= kt1 ? kt + 1 : kt1;
          load_k(fb, kwb + k1 * 4096, c, q4);
          load_v(fb, vwb + k1 * 4096, c, q4);
          if (kt * 64 >= tok0 + 3 - 511 && kt * 64 + 63 <= tok0) attn_compute<false>(sw, fa, qf, kt * 64, t_c - 511, t_c, true, q4);
          else attn_compute<true>(sw, fa, qf, kt * 64, t_c - 511, t_c, true, q4);
          const int k2 = kt + 2 <= kt1 ? kt + 2 : kt1;
          load_k(fa, kwb + k2 * 4096, c, q4);
          load_v(fa, vwb + k2 * 4096, c, q4);
          if (kt + 1 <= kt1) {
            if ((kt + 1) * 64 >= tok0 + 3 - 511 && (kt + 1) * 64 + 63 <= tok0) attn_compute<false>(sw, fb, qf, (kt + 1) * 64, t_c - 511, t_c, true, q4);
            else attn_compute<true>(sw, fb, qf, (kt + 1) * 64, t_c - 511, t_c, true, q4);
          }
        }
        const float inv = sm_invl(sw) * GATESb[trow * 48 + head * 3 + 2];
#pragma unroll
        for (int dt = 0; dt < 4; ++dt)
#pragma unroll
          for (int i = 0; i < 4; ++i) oc[dt][i] = stash[(dt * 4 + i) * 64 + lane] + sw.o[dt][i] * inv;
      }
      __builtin_amdgcn_wave_barrier();
#pragma unroll
      for (int dt = 0; dt < 4; ++dt) {
        const size_t idx = trow * 1024 + head * 64 + dt * 16 + q4 * 4;
        const uint2 zz = *(const uint2*)(SZb + idx);
        uint2 o;
        o.x = pack2(oc[dt][0] * bflo(zz.x), oc[dt][1] * bfhi(zz.x));
        o.y = pack2(oc[dt][2] * bflo(zz.y), oc[dt][3] * bfhi(zz.y));
        *(uint2*)(Ob + idx) = o;
      }
    }
  }
}
  xcd_barrier(xb);

  PH(5) {
  REFRESH();
  {
    auto afn = [&](int row, int k) { return Ob + (size_t)row * 1024 + k; };
    const int lane_ = lane;
    auto epi = [&](f32x16(&accf)[2][4], int mb, int nb, auto nio_) {
      constexpr int NIO = decltype(nio_)::value;
      int lane = lane_;
      asm volatile("" : "+v"(lane));
      stage_add_f32<NIO>(smem + wave * 16384, lane, accf, p.x + (size_t)mb * 1024 + nb, p.out + (size_t)mb * 1024 + nb, 1024);
    };
    FOR_TILES_XCD(4, mt, nt) gemm_tile256(smem, tid, afn, wt_nsa_out, 1024, mt * 256, nt * 256, epi);
  }
  }
  xcd_barrier(xb);

  PH(6) {
  REFRESH();
  rmsnorm_to_bf16(p.out, p.norm_w + 1024, Hb, gw, nw, lane);
  }
  xcd_barrier(xb);

  PH(7) {
  REFRESH();
  {
    auto afn = [&](int row, int k) { return Hb + (size_t)row * 1024 + k; };
    const int lane_ = lane;
    auto epi = [&](f32x16(&accf)[2][4], int mb, int nb, auto nio_) {
      constexpr int NIO = decltype(nio_)::value;
      int lane = lane_;
      asm volatile("" : "+v"(lane));
      const int l31 = lane & 31, lh = lane >> 5;
      const int sect = nb >> 10, cb = nb & 1023;
      char* wlds = smem + wave * 8192;
      if (sect == 1) {
#pragma unroll
        for (int mi = 0; mi < 2; ++mi)
#pragma unroll
          for (int ni = 0; ni < 2; ++ni) {
            const int col = cb + ni * 32 + l31;
            const float lb = lbv[col];
#pragma unroll
            for (int i = 0; i < 16; ++i) {
              const int row = mb + mi * 32 + (i >> 2) * 8 + lh * 4 + (i & 3);
              float xv_ = accf[mi][NIO + ni][i];
              asm volatile("" : "+v"(xv_));
              LOGFb[(size_t)row * 1024 + col] = __logf(lb + (1.f - lb) * sigmoidf_(xv_));
              if ((i & 3) == 3) asm volatile("" ::: "memory");
            }
          }
      } else if (sect == 2) {
        auto vf = [&](int mi, int i) { return F2{accf[mi][NIO + 0][i], accf[mi][NIO + 1][i]}; };
        stage_out<0>(wlds, lane, vf, VHb + (size_t)mb * 1024 + cb, 1024);
      } else {
        auto vf = [&](int mi, int i) { return F2{siluf_(accf[mi][NIO + 0][i]), siluf_(accf[mi][NIO + 1][i])}; };
        stage_out<0>(wlds, lane, vf, (sect == 0 ? QHb : SZHb) + (size_t)mb * 1024 + cb, 1024);
      }
    };
    FOR_TILES_XCD(16, mt, nt) gemm_tile256(smem, tid, afn, wt_hg_in, 1024, mt * 256, nt * 256, epi);
  }
  }
  xcd_barrier(xb);

  float* bq = (float*)smem;
  u16* kT = (u16*)smem;
  u16* vT = (u16*)(smem + 34816);
  float* segs = (float*)(smem + 34816 + 18432);
  float* red = segs + 1024;

  PH(8) {
  REFRESH();
  for (int u = blockIdx.x; u < 4096; u += gridDim.x) {
    const int chunk = u & 255, h = (u >> 8) & 7, b = u >> 11;
    const int row0 = b * SEQ + chunk * 64;
    uint4 uvp[2];
#pragma unroll
    for (int sp2 = 0; sp2 < 2; ++sp2)
      uvp[sp2] = *(const uint4*)(VHb + (size_t)(row0 + (tid >> 4) + sp2 * 32) * 1024 + h * 128 + (tid & 15) * 8);
    float lf[16], bb[16], total;
    hg_scan(tid, LOGFb, row0, h, segs, lf, bb, total);
    {
      const int k = tid & 127, seg = tid >> 7;
      float kv[16];
#pragma unroll
      for (int i = 0; i < 16; ++i) kv[i] = (1.f - __expf(lf[i])) * __expf(total - bb[i]);
#pragma unroll
      for (int hh = 0; hh < 2; ++hh) {
        uint4 o;
        o.x = pack2(kv[hh * 8 + 0], kv[hh * 8 + 1]);
        o.y = pack2(kv[hh * 8 + 2], kv[hh * 8 + 3]);
        o.z = pack2(kv[hh * 8 + 4], kv[hh * 8 + 5]);
        o.w = pack2(kv[hh * 8 + 6], kv[hh * 8 + 7]);
        *(uint4*)(kT + k * 72 + seg * 16 + hh * 8) = o;
      }
      if (seg == 0) DCb[u * 128 + k] = __expf(total);
    }
#pragma unroll
    for (int sp2 = 0; sp2 < 2; ++sp2) {
      const int s = (tid >> 4) + sp2 * 32, v8 = (tid & 15) * 8;
      const uint4 uv = uvp[sp2];
      const unsigned a[4] = {uv.x, uv.y, uv.z, uv.w};
#pragma unroll
      for (int j = 0; j < 8; ++j) vT[(v8 + j) * 72 + s] = (u16)((j & 1) ? (a[j >> 1] >> 16) : (a[j >> 1] & 0xffffu));
    }
    __syncthreads();
    {
      const int c = lane & 15, q4 = lane >> 4;
      const int kt8 = wave;
      bf16x8 af[2];
#pragma unroll
      for (int ks = 0; ks < 2; ++ks) af[ks] = ld8(kT + (kt8 * 16 + c) * 72 + ks * 32 + q4 * 8);
#pragma unroll
      for (int vv = 0; vv < 8; ++vv) {
        const int vt = vv;
        f32x4 a = {0.f, 0.f, 0.f, 0.f};
#pragma unroll
        for (int ks = 0; ks < 2; ++ks) a = mfma16(af[ks], ld8(vT + (vt * 16 + c) * 72 + ks * 32 + q4 * 8), a);
        uint2 o;
        o.x = pack2(a[0], a[1]);
        o.y = pack2(a[2], a[3]);
        *(uint2*)(STb + ((size_t)u * 128 + vt * 16 + c) * 128 + kt8 * 16 + q4 * 4) = o;
      }
    }
    __syncthreads();
  }
  }
  xcd_barrier(xb);

  PH(9) {
  REFRESH();
  for (int e = gt; e < 131072; e += ngt) {
    const int bh = e >> 13, rem = e & 8191, v = rem >> 6, k2 = (rem & 63) * 2;
    float S0 = 0.f, S1 = 0.f;
    unsigned* sp = (unsigned*)(STb + ((size_t)(bh * 256) * 128 + v) * 128 + k2);
    const float* dp = DCb + (size_t)(bh * 256) * 128 + k2;
#pragma unroll 8
    for (int ch = 0; ch < 256; ++ch) {
      const unsigned a = sp[(size_t)ch * 8192];
      const float2 d = *(const float2*)(dp + ch * 128);
      sp[(size_t)ch * 8192] = pack2(S0, S1);
      S0 = d.x * S0 + bflo(a);
      S1 = d.y * S1 + bfhi(a);
    }
  }
  }
  xcd_barrier(xb);

  PH(10) {
  REFRESH();
  u16* kTl = (u16*)(smem + 58368);
  u16* qal = (u16*)(smem + 75776);
  u16* q1l = (u16*)(smem + 93184);
  for (int u = blockIdx.x; u < 4096; u += gridDim.x) {
    const int chunk = u & 255, h = (u >> 8) & 7, b = u >> 11;
    const int row0 = b * SEQ + chunk * 64;
    const int ps = tid >> 3, pk = (tid & 7) * 16;
    const uint4 uq0 = *(const uint4*)(QHb + (size_t)(row0 + ps) * 1024 + h * 128 + pk);
    const uint4 uq1 = *(const uint4*)(QHb + (size_t)(row0 + ps) * 1024 + h * 128 + pk + 8);
    uint4 uvp[2];
#pragma unroll
    for (int sp2 = 0; sp2 < 2; ++sp2)
      uvp[sp2] = *(const uint4*)(VHb + (size_t)(row0 + (tid >> 4) + sp2 * 32) * 1024 + h * 128 + (tid & 15) * 8);
    bf16x8 sfr[4][4];
    uint2 zzp[4];
    {
      const int c_ = lane & 15, q4_ = lane >> 4, I_ = wave >> 1, vq_ = wave & 1;
#pragma unroll
      for (int vv = 0; vv < 4; ++vv) {
        const u16* sp = STb + ((size_t)u * 128 + (vq_ * 4 + vv) * 16 + c_) * 128 + q4_ * 8;
#pragma unroll
        for (int kk = 0; kk < 4; ++kk) sfr[vv][kk] = ld8(sp + kk * 32);
        zzp[vv] = *(const uint2*)(SZHb + (size_t)(row0 + I_ * 16 + c_) * 1024 + h * 128 + (vq_ * 4 + vv) * 16 + q4_ * 4);
      }
    }
    {
      float lf[16], bb[16], total;
      hg_scan(tid, LOGFb, row0, h, segs, lf, bb, total);
      const int k = tid & 127, seg = tid >> 7;
#pragma unroll
      for (int i = 0; i < 16; ++i) bq[(seg * 16 + i) * 132 + k] = bb[i];
    }
#pragma unroll
    for (int sp2 = 0; sp2 < 2; ++sp2) {
      const int s = (tid >> 4) + sp2 * 32, v8 = (tid & 15) * 8;
      const uint4 uv = uvp[sp2];
      const unsigned a[4] = {uv.x, uv.y, uv.z, uv.w};
#pragma unroll
      for (int j = 0; j < 8; ++j) vT[(v8 + j) * 72 + s] = (u16)((j & 1) ? (a[j >> 1] >> 16) : (a[j >> 1] & 0xffffu));
    }
    __syncthreads();
    {
      const unsigned aq[8] = {uq0.x, uq0.y, uq0.z, uq0.w, uq1.x, uq1.y, uq1.z, uq1.w};
      const int spv = ps > 0 ? ps - 1 : 0;
      float kt_[16], qa_[16], q1_[16];
#pragma unroll
      for (int g4 = 0; g4 < 4; ++g4) {
        const float4 bs4 = *(const float4*)(bq + ps * 132 + pk + g4 * 4);
        const float4 bp4 = *(const float4*)(bq + spv * 132 + pk + g4 * 4);
        const float4 bm4 = *(const float4*)(bq + 31 * 132 + pk + g4 * 4);
        const float bsv[4] = {bs4.x, bs4.y, bs4.z, bs4.w};
        const float bpv[4] = {bp4.x, bp4.y, bp4.z, bp4.w};
        const float bmv[4] = {bm4.x, bm4.y, bm4.z, bm4.w};
#pragma unroll
        for (int jj = 0; jj < 4; ++jj) {
          const int j = g4 * 4 + jj;
          const float qv = (j & 1) ? bfhi(aq[j >> 1]) : bflo(aq[j >> 1]);
          const float bs = bsv[jj], bp = ps > 0 ? bpv[jj] : 0.f, bm = bmv[jj];
          kt_[j] = (1.f - __expf(bs - bp)) * __expf(bm - bs);
          qa_[j] = qv * __expf(bs - bm);
          q1_[j] = qv * __expf(bs);
        }
      }
#pragma unroll
      for (int hh = 0; hh < 2; ++hh) {
        uint4 o0, o1, o2;
        o0.x = pack2(kt_[hh * 8 + 0], kt_[hh * 8 + 1]);
        o0.y = pack2(kt_[hh * 8 + 2], kt_[hh * 8 + 3]);
        o0.z = pack2(kt_[hh * 8 + 4], kt_[hh * 8 + 5]);
        o0.w = pack2(kt_[hh * 8 + 6], kt_[hh * 8 + 7]);
        o1.x = pack2(qa_[hh * 8 + 0], qa_[hh * 8 + 1]);
        o1.y = pack2(qa_[hh * 8 + 2], qa_[hh * 8 + 3]);
        o1.z = pack2(qa_[hh * 8 + 4], qa_[hh * 8 + 5]);
        o1.w = pack2(qa_[hh * 8 + 6], qa_[hh * 8 + 7]);
        o2.x = pack2(q1_[hh * 8 + 0], q1_[hh * 8 + 1]);
        o2.y = pack2(q1_[hh * 8 + 2], q1_[hh * 8 + 3]);
        o2.z = pack2(q1_[hh * 8 + 4], q1_[hh * 8 + 5]);
        o2.w = pack2(q1_[hh * 8 + 6], q1_[hh * 8 + 7]);
        *(uint4*)(kTl + ps * 136 + pk + hh * 8) = o0;
        *(uint4*)(qal + ps * 136 + pk + hh * 8) = o1;
        *(uint4*)(q1l + ps * 136 + pk + hh * 8) = o2;
      }
    }
    __syncthreads();
    const int c = lane & 15, q4 = lane >> 4;
    const int I = wave >> 1, vq = wave & 1;
    const int t = I * 16 + c;
    f32x4 o[4];
#pragma unroll
    for (int vv = 0; vv < 4; ++vv) o[vv] = f32x4{0.f, 0.f, 0.f, 0.f};
    {
      bf16x8 q1[4], qa[4];
#pragma unroll
      for (int kk = 0; kk < 4; ++kk) {
        qa[kk] = ld8(qal + t * 136 + kk * 32 + q4 * 8);
        q1[kk] = ld8(q1l + t * 136 + kk * 32 + q4 * 8);
      }
      f32x4 at[4];
#pragma unroll
      for (int J = 0; J < 4; ++J) {
        at[J] = f32x4{0.f, 0.f, 0.f, 0.f};
        if (J <= I) {
#pragma unroll
          for (int kk = 0; kk < 4; ++kk) at[J] = mfma16(ld8(kTl + (J * 16 + c) * 136 + kk * 32 + q4 * 8), qa[kk], at[J]);
#pragma unroll
          for (int i = 0; i < 4; ++i)
            if (J * 16 + q4 * 4 + i > t) at[J][i] = 0.f;
        }
      }
#pragma unroll
      for (int a = 0; a < 2; ++a) {
        if (2 * a <= I) {
          const bf16x8 pb = pack8(at[2 * a], at[2 * a + 1]);
#pragma unroll
          for (int vv = 0; vv < 4; ++vv) {
            const u16* vp = vT + ((vq * 4 + vv) * 16 + c) * 72 + a * 32 + q4 * 4;
            o[vv] = mfma16(ld4x2(vp, vp + 16), pb, o[vv]);
          }
        }
      }
#pragma unroll
      for (int vv = 0; vv < 4; ++vv) {
#pragma unroll
        for (int kk = 0; kk < 4; ++kk) o[vv] = mfma16(sfr[vv][kk], q1[kk], o[vv]);
      }
    }
    {
      float ss = 0.f;
#pragma unroll
      for (int vv = 0; vv < 4; ++vv)
#pragma unroll
        for (int i = 0; i < 4; ++i) ss += o[vv][i] * o[vv][i];
      ss += __shfl_xor(ss, 16);
      ss += __shfl_xor(ss, 32);
      if (q4 == 0) red[t * 2 + vq] = ss;
    }
    __syncthreads();
    {
      const float tot = red[t * 2 + 0] + red[t * 2 + 1];
      const float rstd = rsqrtf(tot * (1.f / 128.f) + EPSV);
#pragma unroll
      for (int vv = 0; vv < 4; ++vv) {
        const int v0 = (vq * 4 + vv) * 16 + q4 * 4;
        const size_t idx = (size_t)(row0 + t) * 1024 + h * 128 + v0;
        const float4 gn = *(const float4*)(p.hg_norm + h * 128 + v0);
        const uint2 zz = zzp[vv];
        uint2 ov;
        ov.x = pack2(o[vv][0] * rstd * gn.x * bflo(zz.x), o[vv][1] * rstd * gn.y * bfhi(zz.x));
        ov.y = pack2(o[vv][2] * rstd * gn.z * bflo(zz.y), o[vv][3] * rstd * gn.w * bfhi(zz.y));
        *(uint2*)(QHb + idx) = ov;
      }
    }
    __syncthreads();
  }
  }
  xcd_barrier(xb);

  PH(11) {
  REFRESH();
  {
    auto afn = [&](int row, int k) { return QHb + (size_t)row * 1024 + k; };
    const int lane_ = lane;
    auto epi = [&](f32x16(&accf)[2][4], int mb, int nb, auto nio_) {
      constexpr int NIO = decltype(nio_)::value;
      int lane = lane_;
      asm volatile("" : "+v"(lane));
      stage_add_f32<NIO>(smem + wave * 16384, lane, accf, p.out + (size_t)mb * 1024 + nb, p.out + (size_t)mb * 1024 + nb, 1024);
    };
    FOR_TILES_XCD(4, mt, nt) gemm_tile256<false>(smem, tid, afn, wt_hg_out, 1024, mt * 256, nt * 256, epi);
  }
  }
  xcd_barrier(xb);

  PH(12) {
  REFRESH();
  for (int row = gw; row < NTOK; row += nw) {
    float4* sp = (float4*)(p.out + (size_t)row * 1024);
    float4 v[4];
    float ss = 0.f;
#pragma unroll
    for (int i = 0; i < 4; ++i) {
      v[i] = sp[lane + 64 * i];
      ss += v[i].x * v[i].x + v[i].y * v[i].y + v[i].z * v[i].z + v[i].w * v[i].w;
    }
    ss = wave_sum(ss);
    const float rstd = rsqrtf(ss * (1.f / 1024.f) + EPSV);
#pragma unroll
    for (int i = 0; i < 4; ++i) {
      const float4 gg = ((const float4*)p.final_norm)[lane + 64 * i];
      sp[lane + 64 * i] = make_float4(v[i].x * rstd * gg.x, v[i].y * rstd * gg.y, v[i].z * rstd * gg.z, v[i].w * rstd * gg.w);
    }
  }
}
}

extern "C" void kernel_launch(void* const* d_in, const int* in_sizes, int n_in, void* d_out, int out_size, void* d_ws,
                              size_t ws_size, hipStream_t stream) {
  (void)in_sizes;
  (void)n_in;
  (void)out_size;
  if (ws_size < WS_NEED) {
    fprintf(stderr, "workspace too small: %zu < %zu\n", ws_size, (size_t)WS_NEED);
    return;
  }
  static int grid_blocks = 0;
  if (!grid_blocks) {
    int dev = 0, cus = 0, per_cu = 0;
    hipGetDevice(&dev);
    hipDeviceGetAttribute(&cus, hipDeviceAttributeMultiprocessorCount, dev);
    hipFuncSetAttribute((const void*)mega, hipFuncAttributeMaxDynamicSharedMemorySize, DYN_LDS);
    hipOccupancyMaxActiveBlocksPerMultiprocessor(&per_cu, mega, NTHR, DYN_LDS);
    if (per_cu < 1) per_cu = 1;
    if (per_cu > 1) per_cu = 1;
    grid_blocks = cus * per_cu;
  }
  Params p{};
  p.x = (const float*)d_in[0];
  p.norm_w = (const float*)d_in[1];
  p.nsa_w_in = (const float*)d_in[2];
  p.pe_k = (const float*)d_in[3];
  p.pe_v = (const float*)d_in[4];
  p.wk1 = (const float*)d_in[5];
  p.wk2 = (const float*)d_in[6];
  p.wv1 = (const float*)d_in[7];
  p.wv2 = (const float*)d_in[8];
  p.nsa_w_out = (const float*)d_in[9];
  p.hg_w_in = (const float*)d_in[10];
  p.lb_logits = (const float*)d_in[11];
  p.hg_norm = (const float*)d_in[12];
  p.hg_w_out = (const float*)d_in[13];
  p.final_norm = (const float*)d_in[14];
  p.out = (float*)d_out;
  p.ws = (char*)d_ws;
  hipMemsetAsync((char*)d_ws + OFF_MISC + 16384, 0, XCD_BAR_WORDS * sizeof(unsigned), stream);
  void* args[] = {&p};
  hipError_t e = hipLaunchCooperativeKernel((void*)mega, dim3(grid_blocks), dim3(NTHR), args, DYN_LDS, stream);
  if (e != hipSuccess) fprintf(stderr, "cooperative launch failed: %s (grid %d)\n", hipGetErrorString(e), grid_blocks);
}
```

```cpp
#include <hip/hip_runtime.h>
#include <hip/hip_cooperative_groups.h>
#include <cstdio>
#include <type_traits>
namespace cg = cooperative_groups;

#define DI __device__ __forceinline__
typedef unsigned short u16;
typedef __attribute__((ext_vector_type(8))) short bf16x8;
typedef __attribute__((ext_vector_type(4))) float f32x4;
typedef __attribute__((ext_vector_type(16))) float f32x16;

constexpr int NTHR = 512;
constexpr int SEQ = 16384;
constexpr int NTOK = 32768;
constexpr int NSA_NP = 3840;
constexpr float EPSV = 1e-6f;
constexpr int DYN_LDS = 131072;
#ifndef PHASES
#define PHASES 0xffff
#endif
#ifndef REPEAT
#define REPEAT 0
#endif
#define PH(n) if ((PHASES >> (n)) & 1) for (int rep_ = 0; rep_ < (((REPEAT >> (n)) & 1) ? 2 : 1); ++rep_)

constexpr size_t MiB = 1u << 20;
constexpr size_t OFF_WT_NSA_IN = 0;
constexpr size_t OFF_WT_HG_IN = 8 * MiB;
constexpr size_t OFF_WT_NSA_OUT = 16 * MiB;
constexpr size_t OFF_WT_HG_OUT = 18 * MiB;
constexpr size_t OFF_WT_K1 = 20 * MiB;
constexpr size_t OFF_WT_V1 = 21 * MiB;
constexpr size_t OFF_ROPE = 22 * MiB;
constexpr size_t OFF_MISC = 26 * MiB;
constexpr size_t ARENA = 27 * MiB;
constexpr size_t OFF_H = ARENA;
constexpr size_t OFF_Q = ARENA + 64 * MiB;
constexpr size_t OFF_KC = ARENA + 128 * MiB;
constexpr size_t OFF_VC = ARENA + 144 * MiB;
constexpr size_t OFF_KS = ARENA + 160 * MiB;
constexpr size_t OFF_VST = ARENA + 176 * MiB;
constexpr size_t OFF_KW = ARENA + 192 * MiB;
constexpr size_t OFF_VWT = ARENA + 208 * MiB;
constexpr size_t OFF_SZ = ARENA + 224 * MiB;
constexpr size_t OFF_GATES = ARENA + 288 * MiB;
constexpr size_t OFF_HID = ARENA + 296 * MiB;
constexpr size_t OFF_KCMP = ARENA + 304 * MiB;
constexpr size_t OFF_VCMPT = ARENA + 305 * MiB;
constexpr size_t OFF_O = ARENA + 306 * MiB;
constexpr size_t OFF_STATES = ARENA;
constexpr size_t OFF_QH = ARENA + 128 * MiB;
constexpr size_t OFF_LOGF = ARENA + 192 * MiB;
constexpr size_t OFF_VH = ARENA + 320 * MiB;
constexpr size_t OFF_SZH = ARENA + 384 * MiB;
constexpr size_t OFF_DC = ARENA + 448 * MiB;
constexpr size_t WS_NEED = ARENA + 450 * MiB;

struct Params {
  const float *x, *norm_w, *nsa_w_in, *pe_k, *pe_v, *wk1, *wk2, *wv1, *wv2, *nsa_w_out, *hg_w_in, *lb_logits, *hg_norm,
      *hg_w_out, *final_norm;
  float* out;
  char* ws;
};

DI u16 f2bf(float f) {
  unsigned u = __float_as_uint(f);
  u += 0x7fffu + ((u >> 16) & 1u);
  return (u16)(u >> 16);
}
DI float bf2f(u16 h) { return __uint_as_float(((unsigned)h) << 16); }
typedef __attribute__((ext_vector_type(2))) float f32x2_;
typedef __attribute__((ext_vector_type(2))) __bf16 bf16x2_;
DI unsigned pack2(float a, float b) {
  f32x2_ v = {a, b};
  return __builtin_bit_cast(unsigned, __builtin_convertvector(v, bf16x2_));
}
DI float exp2f_(float x) { return __builtin_amdgcn_exp2f(x); }
DI float dpp_xor1(float v) { return __builtin_bit_cast(float, __builtin_amdgcn_mov_dpp(__builtin_bit_cast(int, v), 0xB1, 0xf, 0xf, true)); }
DI float dpp_xor2(float v) { return __builtin_bit_cast(float, __builtin_amdgcn_mov_dpp(__builtin_bit_cast(int, v), 0x4E, 0xf, 0xf, true)); }
DI float bflo(unsigned u) { return __uint_as_float(u << 16); }
DI float bfhi(unsigned u) { return __uint_as_float(u & 0xffff0000u); }
DI float sigmoidf_(float x) { return __builtin_amdgcn_rcpf(1.f + __expf(-x)); }
DI float siluf_(float x) { return x * __builtin_amdgcn_rcpf(1.f + __expf(-x)); }
DI float wave_sum(float v) {
#pragma unroll
  for (int o = 32; o > 0; o >>= 1) v += __shfl_xor(v, o);
  return v;
}
DI f32x4 mfma16(bf16x8 a, bf16x8 b, f32x4 c) { return __builtin_amdgcn_mfma_f32_16x16x32_bf16(a, b, c, 0, 0, 0); }
DI bf16x8 pack8(f32x4 lo, f32x4 hi) {
  uint4 u;
  u.x = pack2(lo[0], lo[1]);
  u.y = pack2(lo[2], lo[3]);
  u.z = pack2(hi[0], hi[1]);
  u.w = pack2(hi[2], hi[3]);
  return __builtin_bit_cast(bf16x8, u);
}
DI bf16x8 ld8(const u16* p) { return *(const bf16x8*)p; }
DI bf16x8 ld4x2(const u16* p0, const u16* p1) {
  uint2 a = *(const uint2*)p0;
  uint2 b = *(const uint2*)p1;
  uint4 u = make_uint4(a.x, a.y, b.x, b.y);
  return __builtin_bit_cast(bf16x8, u);
}

extern __shared__ __attribute__((aligned(16))) char dyn_lds[];
#define RAW_BARRIER()                                   \
  do {                                                  \
    asm volatile("s_waitcnt lgkmcnt(0)" ::: "memory"); \
    __builtin_amdgcn_s_barrier();                       \
  } while (0)
template <bool PRE12 = true, class AF, class EF>
DI void gemm_tile256(char* smem, const int tid, AF afn, const u16* __restrict__ Bt, int K, int m0, int n0, EF epi) {
  const int lane = tid & 63, wave = tid >> 6;
  const int wm = wave >> 1, wn = wave & 1;
  f32x16 acc[2][4];
#pragma unroll
  for (int mi = 0; mi < 2; ++mi)
#pragma unroll
    for (int ni = 0; ni < 4; ++ni)
#pragma unroll
      for (int i = 0; i < 16; ++i) acc[mi][ni][i] = 0.f;
  const int KT = K >> 5;
  const int r0 = wave * 16 + (lane >> 2), r1 = r0 + 128;
  const int c0 = ((lane & 3) ^ ((r0 >> 2) & 3)) * 8, c1 = ((lane & 3) ^ ((r1 >> 2) & 3)) * 8;
  const u16* gb0 = Bt + (size_t)(n0 + r0) * K + c0;
  const u16* gb1 = Bt + (size_t)(n0 + r1) * K + c1;
  auto glds = [&](int kt, int st) {
    char* sb = dyn_lds + st * 32768 + wave * 1024;
    __builtin_amdgcn_global_load_lds((const unsigned*)afn(m0 + r0, kt * 32 + c0), (unsigned*)(sb), 16, 0, 0);
    __builtin_amdgcn_global_load_lds((const unsigned*)afn(m0 + r1, kt * 32 + c1), (unsigned*)(sb + 8192), 16, 0, 0);
    __builtin_amdgcn_global_load_lds((const unsigned*)(gb0 + kt * 32), (unsigned*)(sb + 16384), 16, 0, 0);
    __builtin_amdgcn_global_load_lds((const unsigned*)(gb1 + kt * 32), (unsigned*)(sb + 16384 + 8192), 16, 0, 0);
  };
  __syncthreads();
  glds(0, 0);
  if (KT > 1) glds(1, 1);
  if (KT > 2) glds(2, 2);
  const int l31 = lane & 31, lh = lane >> 5;
  for (int kt = 0; kt < KT; ++kt) {
    if (kt + 2 < KT) asm volatile("s_waitcnt vmcnt(8)" ::: "memory");
    else if (kt + 1 < KT) asm volatile("s_waitcnt vmcnt(4)" ::: "memory");
    else asm volatile("s_waitcnt vmcnt(0)" ::: "memory");
    RAW_BARRIER();
    if (kt + 3 < KT) glds(kt + 3, (kt + 3) & 3);
    const char* cA = dyn_lds + (kt & 3) * 32768;
    const char* cB = cA + 16384;
    {
      bf16x8 af0[2], bf0[4], af1[2], bf1[4];
      auto rd = [&](bf16x8 (&af)[2], bf16x8 (&bfr)[4], int ks) {
        const int ch = ks * 2 + lh;
#pragma unroll
        for (int mi = 0; mi < 2; ++mi) {
          const int row = wm * 64 + mi * 32 + l31;
          af[mi] = *(const bf16x8*)(cA + row * 64 + ((ch ^ ((row >> 2) & 3)) << 4));
        }
#pragma unroll
        for (int ni = 0; ni < 4; ++ni) {
          const int row = wn * 128 + ni * 32 + l31;
          bfr[ni] = *(const bf16x8*)(cB + row * 64 + ((ch ^ ((row >> 2) & 3)) << 4));
        }
      };
      auto mm = [&](const bf16x8 (&af)[2], const bf16x8 (&bfr)[4]) {
#pragma unroll
        for (int mi = 0; mi < 2; ++mi)
#pragma unroll
          for (int ni = 0; ni < 4; ++ni)
            acc[mi][ni] = __builtin_amdgcn_mfma_f32_32x32x16_bf16(af[mi], bfr[ni], acc[mi][ni], 0, 0, 0);
      };
      if (PRE12) {
        rd(af0, bf0, 0);
        rd(af1, bf1, 1);
        __builtin_amdgcn_sched_barrier(0);
        mm(af0, bf0);
        mm(af1, bf1);
      } else {
        rd(af0, bf0, 0);
        mm(af0, bf0);
        rd(af0, bf0, 1);
        mm(af0, bf0);
      }
    }
  }
  RAW_BARRIER();
  epi(acc, m0 + wm * 64, n0 + wn * 128, std::integral_constant<int, 0>());
  epi(acc, m0 + wm * 64, n0 + wn * 128 + 64, std::integral_constant<int, 2>());
}

struct F2 {
  float a, b;
};
DI int vperm_pos(int key64) {
  const int a = key64 >> 5, w = key64 & 31;
  return a * 32 + ((w & 15) >> 2) * 8 + (w & 3) + ((w >> 4) << 2);
}
DI unsigned cvt4_fp8(float a, float b, float c, float d) {
  int w = __builtin_amdgcn_cvt_pk_fp8_f32(a, b, 0, false);
  w = __builtin_amdgcn_cvt_pk_fp8_f32(c, d, w, true);
  return (unsigned)w;
}
DI uint2 bf8_to_fp8(uint4 u) {
  uint2 r;
  r.x = cvt4_fp8(bflo(u.x), bfhi(u.x), bflo(u.y), bfhi(u.y));
  r.y = cvt4_fp8(bflo(u.z), bfhi(u.z), bflo(u.w), bfhi(u.w));
  return r;
}
template <int MODE, bool FP8 = false, class VF>
DI void stage_out(char* wlds, int lane, VF vf, u16* __restrict__ dst, int ld) {
  asm volatile("" : "+v"(lane)::"memory");
  const int l31 = lane & 31, lh = lane >> 5;
  if (MODE != 2) {
    const int w0 = (lh * 4 + 0) * 128 + (((l31 >> 3) ^ (lh * 4 + 0)) << 4) + (l31 & 7) * 2;
    const int w1 = (lh * 4 + 1) * 128 + (((l31 >> 3) ^ (lh * 4 + 1)) << 4) + (l31 & 7) * 2;
    const int w2 = (lh * 4 + 2) * 128 + (((l31 >> 3) ^ (lh * 4 + 2)) << 4) + (l31 & 7) * 2;
    const int w3 = (lh * 4 + 3) * 128 + (((l31 >> 3) ^ (lh * 4 + 3)) << 4) + (l31 & 7) * 2;
#pragma unroll
    for (int mi = 0; mi < 2; ++mi)
#pragma unroll
      for (int i = 0; i < 16; ++i) {
        const F2 v = vf(mi, i);
        const unsigned pk = pack2(v.a, v.b);
        const int wj = (i & 3) == 0 ? w0 : ((i & 3) == 1 ? w1 : ((i & 3) == 2 ? w2 : w3));
        const int cofs = (mi * 32 + (i >> 2) * 8) * 128;
        *(u16*)(wlds + wj + cofs) = (u16)(pk & 0xffffu);
        *(u16*)(wlds + (wj ^ 64) + cofs) = (u16)(pk >> 16);
        if ((i & 1) == 1) asm volatile("" ::: "memory");
      }
  } else {
#pragma unroll
    for (int mi = 0; mi < 2; ++mi)
#pragma unroll
      for (int i4 = 0; i4 < 4; ++i4) {
        const int key0 = mi * 32 + i4 * 8 + lh * 4;
        const int slot0 = vperm_pos(key0);
        const F2 v0 = vf(mi, i4 * 4 + 0), v1 = vf(mi, i4 * 4 + 1), v2 = vf(mi, i4 * 4 + 2), v3 = vf(mi, i4 * 4 + 3);
        uint2 oa, ob;
        oa.x = pack2(v0.a, v1.a);
        oa.y = pack2(v2.a, v3.a);
        ob.x = pack2(v0.b, v1.b);
        ob.y = pack2(v2.b, v3.b);
        const int da = l31, db = 32 + l31;
        *(uint2*)(wlds + da * 128 + (((slot0 >> 3) ^ (da & 7)) << 4) + (slot0 & 7) * 2) = oa;
        *(uint2*)(wlds + db * 128 + (((slot0 >> 3) ^ (db & 7)) << 4) + (slot0 & 7) * 2) = ob;
        asm volatile("" ::: "memory");
      }
  }
  asm volatile("" ::: "memory");
  __builtin_amdgcn_wave_barrier();
  if (MODE == 0) {
#pragma unroll
    for (int it = 0; it < 8; ++it) {
      const int row = it * 8 + (lane >> 3), ch = lane & 7;
      const uint4 v = *(const uint4*)(wlds + row * 128 + ((ch ^ (row & 7)) << 4));
      *(uint4*)(dst + (size_t)row * ld + ch * 8) = v;
    }
  } else if (FP8) {
#pragma unroll
    for (int it = 0; it < 4; ++it) {
      const int r = lane;
      const uint4 v0 = *(const uint4*)(wlds + r * 128 + ((it ^ (r & 7)) << 4));
      const uint4 v1 = *(const uint4*)(wlds + r * 128 + (((it + 4) ^ (r & 7)) << 4));
      const uint2 c0 = bf8_to_fp8(v0), c1 = bf8_to_fp8(v1);
      *(uint4*)((char*)dst + (((r >> 4) * 64 + it * 16 + (r & 15)) * 16)) = make_uint4(c0.x, c0.y, c1.x, c1.y);
    }
  } else {
#pragma unroll
    for (int it = 0; it < 8; ++it) {
      const int r = lane;
      const uint4 v = *(const uint4*)(wlds + r * 128 + ((it ^ (r & 7)) << 4));
      const int off = MODE == 1 ? ((((r >> 4) * 2 + (it >> 2)) * 64 + (it & 3) * 16 + (r & 15)) * 8)
                                : ((((it >> 2) * 4 + (r >> 4)) * 64 + (it & 3) * 16 + (r & 15)) * 8);
      *(uint4*)(dst + off) = v;
    }
  }
  asm volatile("" ::: "memory");
  __builtin_amdgcn_wave_barrier();
}

template <int NIO>
DI void stage_add_f32(char* wlds, int lane, const f32x16 (&accf)[2][4], const float* src, float* dst, int ld) {
  asm volatile("" : "+v"(lane)::"memory");
  const int l31 = lane & 31, lh = lane >> 5;
  float* wf = (float*)wlds;
#pragma unroll
  for (int mi = 0; mi < 2; ++mi)
#pragma unroll
    for (int ni = 0; ni < 2; ++ni)
#pragma unroll
      for (int i = 0; i < 16; ++i) wf[(mi * 32 + (i >> 2) * 8 + lh * 4 + (i & 3)) * 64 + ni * 32 + l31] = accf[mi][NIO + ni][i];
  asm volatile("" ::: "memory");
  __builtin_amdgcn_wave_barrier();
  const int r0 = lane >> 4, c4 = lane & 15;
#pragma unroll
  for (int hb = 0; hb < 4; ++hb) {
    float4 xv[4];
#pragma unroll
    for (int it = 0; it < 4; ++it) xv[it] = *(const float4*)(src + (size_t)((hb * 4 + it) * 4 + r0) * ld + c4 * 4);
#pragma unroll
    for (int it = 0; it < 4; ++it) {
      const int row = (hb * 4 + it) * 4 + r0;
      const float4 a = *(const float4*)(wf + row * 64 + c4 * 4);
      *(float4*)(dst + (size_t)row * ld + c4 * 4) = make_float4(xv[it].x + a.x, xv[it].y + a.y, xv[it].z + a.z, xv[it].w + a.w);
    }
  }
  asm volatile("" ::: "memory");
  __builtin_amdgcn_wave_barrier();
}

template <class CM>
DI void transpose_w(char* smem, const int tid, const float* __restrict__ src, int srcN, u16* __restrict__ dst, int K, int Ndst, CM colmap) {
  float* tile = (float*)smem;
  const int nkt = K >> 6, nnt = Ndst >> 6;
  for (int t = blockIdx.x; t < nkt * nnt; t += gridDim.x) {
    const int kt = t % nkt, nt = t / nkt;
#pragma unroll
    for (int r = 0; r < 8; ++r) {
      const int i = (tid >> 6) + 8 * r, j = tid & 63;
      const int sc = colmap(nt * 64 + j);
      tile[i * 65 + j] = sc >= 0 ? src[(size_t)(kt * 64 + i) * srcN + sc] : 0.f;
    }
    __syncthreads();
#pragma unroll
    for (int r = 0; r < 8; ++r) {
      const int jj = (tid >> 6) + 8 * r, ii = tid & 63;
      dst[(size_t)(nt * 64 + jj) * K + kt * 64 + ii] = f2bf(tile[ii * 65 + jj]);
    }
    __syncthreads();
  }
}

DI void rmsnorm_to_bf16(const float* __restrict__ src, const float* __restrict__ g, u16* __restrict__ dst, int gw, int nw, const int lane) {
  for (int row0 = gw; row0 < NTOK; row0 += 4 * nw) {
    float4 v[4][4];
#pragma unroll
    for (int r = 0; r < 4; ++r) {
      const int row = row0 + r * nw < NTOK ? row0 + r * nw : row0;
      const float4* sp = (const float4*)(src + (size_t)row * 1024);
#pragma unroll
      for (int i = 0; i < 4; ++i) v[r][i] = sp[lane + 64 * i];
    }
#pragma unroll
    for (int r = 0; r < 4; ++r) {
      const int row = row0 + r * nw;
      if (row < NTOK) {
        float ss = 0.f;
#pragma unroll
        for (int i = 0; i < 4; ++i) ss += v[r][i].x * v[r][i].x + v[r][i].y * v[r][i].y + v[r][i].z * v[r][i].z + v[r][i].w * v[r][i].w;
        ss = wave_sum(ss);
        const float rstd = rsqrtf(ss * (1.f / 1024.f) + EPSV);
#pragma unroll
        for (int i = 0; i < 4; ++i) {
          const float4 gg = ((const float4*)g)[lane + 64 * i];
          uint2 o;
          o.x = pack2(v[r][i].x * rstd * gg.x, v[r][i].y * rstd * gg.y);
          o.y = pack2(v[r][i].z * rstd * gg.z, v[r][i].w * rstd * gg.w);
          *(uint2*)(dst + (size_t)row * 1024 + (lane + 64 * i) * 4) = o;
        }
      }
    }
  }
}

DI void sincos_reduced(double a, float& c, float& s) {
  const double inv2pi = 0.15915494309189533577;
  const double tp_hi = 6.283185307179586232, tp_lo = 2.4492935982947064e-16;
  double n = rint(a * inv2pi);
  double r = fma(-n, tp_hi, a);
  r = fma(-n, tp_lo, r);
  const double r2 = r * r;
  double sp = 0.0, cp = 0.0;
  double fs = 1.0;
  const double SC[13] = {1.0,
                         -1.0 / 6.0,
                         1.0 / 120.0,
                         -1.0 / 5040.0,
                         1.0 / 362880.0,
                         -1.0 / 39916800.0,
                         1.0 / 6227020800.0,
                         -1.0 / 1307674368000.0,
                         1.0 / 355687428096000.0,
                         -1.0 / 121645100408832000.0,
                         1.0 / 51090942171709440000.0,
                         -1.0 / 25852016738884976640000.0,
                         1.0 / 15511210043330985984000000.0};
  const double CC[13] = {1.0,
                         -1.0 / 2.0,
                         1.0 / 24.0,
                         -1.0 / 720.0,
                         1.0 / 40320.0,
                         -1.0 / 3628800.0,
                         1.0 / 479001600.0,
                         -1.0 / 87178291200.0,
                         1.0 / 20922789888000.0,
                         -1.0 / 6402373705728000.0,
                         1.0 / 2432902008176640000.0,
                         -1.0 / 1124000727777607680000.0,
                         1.0 / 620448401733239439360000.0};
  (void)fs;
#pragma unroll
  for (int k = 12; k >= 0; --k) {
    sp = sp * r2 + SC[k];
    cp = cp * r2 + CC[k];
  }
  s = (float)(sp * r);
  c = (float)cp;
}

struct SMState {
  float m, l;
  f32x4 o[4];
};
struct KVFrag {
  bf16x8 k[8];
  bf16x8 v[8];
};
DI int kfrag_off(int key, int dim) {
  return ((((key >> 4) * 2 + (dim >> 5)) * 64) + ((dim >> 3) & 3) * 16 + (key & 15)) * 8 + (dim & 7);
}
DI int vfrag_off(int d, int key) {
  const int w = key & 31;
  return ((((key >> 5) * 4 + (d >> 4)) * 64) + ((w & 15) >> 2) * 16 + (d & 15)) * 8 + (w & 3) + ((w >> 4) << 2);
}
DI void load_k(KVFrag& f, const u16* __restrict__ kbase, int c, int q4) {
  const u16* p = kbase + (q4 * 16 + c) * 8;
#pragma unroll
  for (int fr = 0; fr < 8; ++fr) f.k[fr] = ld8(p + fr * 512);
}
DI void load_v(KVFrag& f, const u16* __restrict__ vtbase, int c, int q4) {
  const u16* p = vtbase + (q4 * 16 + c) * 8;
#pragma unroll
  for (int fr = 0; fr < 8; ++fr) f.v[fr] = ld8(p + fr * 512);
}
DI void qk_scores(f32x4 (&s)[4], const KVFrag& f, const bf16x8 (&qf)[2]) {
#pragma unroll
  for (int st = 0; st < 4; ++st) {
    f32x4 z = {0.f, 0.f, 0.f, 0.f};
    z = mfma16(f.k[st * 2], qf[0], z);
    z = mfma16(f.k[st * 2 + 1], qf[1], z);
    s[st] = z;
  }
}
template <bool MASKED>
DI void attn_compute(SMState& st, const KVFrag& f, const bf16x8 (&qf)[2], int pos0, int tlo, int thi, bool active, int q4) {
  f32x4 s[4];
  qk_scores(s, f, qf);
  if (MASKED) {
#pragma unroll
    for (int t4 = 0; t4 < 4; ++t4)
#pragma unroll
      for (int i = 0; i < 4; ++i) {
        const int pos = pos0 + t4 * 16 + q4 * 4 + i;
        s[t4][i] = (pos >= tlo && pos <= thi) ? s[t4][i] : -1e30f;
      }
  }
  float mt = fmaxf(fmaxf(s[0][0], s[0][1]), fmaxf(s[0][2], s[0][3]));
#pragma unroll
  for (int t4 = 1; t4 < 4; ++t4) mt = fmaxf(mt, fmaxf(fmaxf(s[t4][0], s[t4][1]), fmaxf(s[t4][2], s[t4][3])));
  mt = fmaxf(mt, __shfl_xor(mt, 16));
  mt = fmaxf(mt, __shfl_xor(mt, 32));
  const float mn = active ? fmaxf(st.m, mt) : st.m;
  const float alpha = exp2f_(st.m - mn);
  float psum = 0.f;
#pragma unroll
  for (int t4 = 0; t4 < 4; ++t4)
#pragma unroll
    for (int i = 0; i < 4; ++i) {
      float pv = exp2f_(s[t4][i] - mn);
      if (MASKED) pv = s[t4][i] > -1e29f ? pv : 0.f;
      s[t4][i] = pv;
      psum += pv;
    }
  psum = active ? psum : 0.f;
  st.l = st.l * alpha + psum;
  st.m = mn;
#pragma unroll
  for (int dt = 0; dt < 4; ++dt) st.o[dt] *= alpha;
  const unsigned am = active ? 0xffffffffu : 0u;
#pragma unroll
  for (int a = 0; a < 2; ++a) {
    uint4 pu = __builtin_bit_cast(uint4, pack8(s[2 * a], s[2 * a + 1]));
    pu.x &= am;
    pu.y &= am;
    pu.z &= am;
    pu.w &= am;
    const bf16x8 pb = __builtin_bit_cast(bf16x8, pu);
#pragma unroll
    for (int dt = 0; dt < 4; ++dt) st.o[dt] = mfma16(f.v[a * 4 + dt], pb, st.o[dt]);
  }
}

struct KV8 {
  uint4 k[4];
  uint4 v[4];
};
DI long mk64(unsigned lo, unsigned hi) { return (long)(((unsigned long long)hi << 32) | (unsigned long long)lo); }
DI f32x4 mfma8(long a, long b, f32x4 c) { return __builtin_amdgcn_mfma_f32_16x16x32_fp8_fp8(a, b, c, 0, 0, 0); }
DI void load_kv8(KV8& f, const char* __restrict__ k8, const char* __restrict__ v8, int lane) {
#pragma unroll
  for (int p = 0; p < 4; ++p) f.k[p] = *(const uint4*)(k8 + (p * 64 + lane) * 16);
#pragma unroll
  for (int p = 0; p < 4; ++p) f.v[p] = *(const uint4*)(v8 + (p * 64 + lane) * 16);
}
template <bool MASKED>
DI void attn_compute8(SMState& st, const KV8& f, const long (&q8)[2], int pos0, int thi, bool active, int q4) {
  f32x4 s[4];
#pragma unroll
  for (int t4 = 0; t4 < 4; ++t4) {
    f32x4 z = {0.f, 0.f, 0.f, 0.f};
    z = mfma8(mk64(f.k[t4].x, f.k[t4].y), q8[0], z);
    z = mfma8(mk64(f.k[t4].z, f.k[t4].w), q8[1], z);
    s[t4] = z;
  }
  if (MASKED) {
#pragma unroll
    for (int t4 = 0; t4 < 4; ++t4)
#pragma unroll
      for (int i = 0; i < 4; ++i) {
        const int pos = pos0 + t4 * 16 + q4 * 4 + i;
        s[t4][i] = pos <= thi ? s[t4][i] : -1e30f;
      }
  }
  float mt = fmaxf(fmaxf(s[0][0], s[0][1]), fmaxf(s[0][2], s[0][3]));
#pragma unroll
  for (int t4 = 1; t4 < 4; ++t4) mt = fmaxf(mt, fmaxf(fmaxf(s[t4][0], s[t4][1]), fmaxf(s[t4][2], s[t4][3])));
  mt = fmaxf(mt, __shfl_xor(mt, 16));
  mt = fmaxf(mt, __shfl_xor(mt, 32));
  const float mn = active ? fmaxf(st.m, mt * 0.125f) : st.m;
  const float alpha = exp2f_(st.m - mn);
  const float eo = 8.f - mn;
  f32x4 ps4 = {0.f, 0.f, 0.f, 0.f};
#pragma unroll
  for (int t4 = 0; t4 < 4; ++t4) {
    const f32x4 ev = s[t4] * 0.125f + eo;
#pragma unroll
    for (int i = 0; i < 4; ++i) {
      float pv = exp2f_(ev[i]);
      if (MASKED) pv = s[t4][i] > -1e29f ? pv : 0.f;
      s[t4][i] = pv;
    }
    ps4 += s[t4];
  }
  float psum = (ps4[0] + ps4[1]) + (ps4[2] + ps4[3]);
  psum = active ? psum : 0.f;
  st.l = st.l * alpha + psum;
  st.m = mn;
#pragma unroll
  for (int dt = 0; dt < 4; ++dt) st.o[dt] *= alpha;
  const unsigned am = active ? 0xffffffffu : 0u;
#pragma unroll
  for (int a = 0; a < 2; ++a) {
    const unsigned p0 = cvt4_fp8(s[2 * a][0], s[2 * a][1], s[2 * a][2], s[2 * a][3]) & am;
    const unsigned p1 = cvt4_fp8(s[2 * a + 1][0], s[2 * a + 1][1], s[2 * a + 1][2], s[2 * a + 1][3]) & am;
    const long pb = mk64(p0, p1);
#pragma unroll
    for (int dt = 0; dt < 4; ++dt)
      st.o[dt] = mfma8(a == 0 ? mk64(f.v[dt].x, f.v[dt].y) : mk64(f.v[dt].z, f.v[dt].w), pb, st.o[dt]);
  }
}

template <bool MASKED>
DI void attn_pair8(SMState& st, const KV8& fa, const KV8& fb, const long (&q8)[2], int pos0, int thi, bool laneA, bool active,
                   bool useB, int q4) {
  f32x4 s[4];
  if (useB) {
    const long zq = 0;
    const long qa0 = laneA ? q8[0] : zq, qa1 = laneA ? q8[1] : zq;
    const long qb0 = laneA ? zq : q8[0], qb1 = laneA ? zq : q8[1];
#pragma unroll
    for (int t4 = 0; t4 < 4; ++t4) {
      f32x4 z = {0.f, 0.f, 0.f, 0.f};
      z = mfma8(mk64(fa.k[t4].x, fa.k[t4].y), qa0, z);
      z = mfma8(mk64(fa.k[t4].z, fa.k[t4].w), qa1, z);
      z = mfma8(mk64(fb.k[t4].x, fb.k[t4].y), qb0, z);
      z = mfma8(mk64(fb.k[t4].z, fb.k[t4].w), qb1, z);
      s[t4] = z;
    }
  } else {
#pragma unroll
    for (int t4 = 0; t4 < 4; ++t4) {
      f32x4 z = {0.f, 0.f, 0.f, 0.f};
      z = mfma8(mk64(fa.k[t4].x, fa.k[t4].y), q8[0], z);
      z = mfma8(mk64(fa.k[t4].z, fa.k[t4].w), q8[1], z);
      s[t4] = z;
    }
  }
#pragma unroll
  for (int t4 = 0; t4 < 4; ++t4) s[t4] = s[t4] * 0.125f;
  if (MASKED) {
#pragma unroll
    for (int t4 = 0; t4 < 4; ++t4)
#pragma unroll
      for (int i = 0; i < 4; ++i) {
        const int pos = pos0 + t4 * 16 + q4 * 4 + i;
        s[t4][i] = pos <= thi ? s[t4][i] : -1e30f;
      }
  }
  float mt = fmaxf(fmaxf(s[0][0], s[0][1]), fmaxf(s[0][2], s[0][3]));
#pragma unroll
  for (int t4 = 1; t4 < 4; ++t4) mt = fmaxf(mt, fmaxf(fmaxf(s[t4][0], s[t4][1]), fmaxf(s[t4][2], s[t4][3])));
  mt = fmaxf(mt, __shfl_xor(mt, 16));
  mt = fmaxf(mt, __shfl_xor(mt, 32));
  const float mn = active ? fmaxf(st.m, mt) : st.m;
  const float alpha = exp2f_(st.m - mn);
  const float eo = 8.f - mn;
  f32x4 ps4 = {0.f, 0.f, 0.f, 0.f};
#pragma unroll
  for (int t4 = 0; t4 < 4; ++t4) {
    const f32x4 ev = s[t4] + eo;
#pragma unroll
    for (int i = 0; i < 4; ++i) {
      float pv = exp2f_(ev[i]);
      if (MASKED) pv = s[t4][i] > -1e29f ? pv : 0.f;
      s[t4][i] = pv;
    }
    ps4 += s[t4];
  }
  float psum = (ps4[0] + ps4[1]) + (ps4[2] + ps4[3]);
  psum = active ? psum : 0.f;
  st.l = st.l * alpha + psum;
  st.m = mn;
#pragma unroll
  for (int dt = 0; dt < 4; ++dt) st.o[dt] *= alpha;
  const unsigned amA = (active && laneA) ? 0xffffffffu : 0u;
  const unsigned amB = (active && !laneA) ? 0xffffffffu : 0u;
#pragma unroll
  for (int a = 0; a < 2; ++a) {
    const unsigned p0 = cvt4_fp8(s[2 * a][0], s[2 * a][1], s[2 * a][2], s[2 * a][3]);
    const unsigned p1 = cvt4_fp8(s[2 * a + 1][0], s[2 * a + 1][1], s[2 * a + 1][2], s[2 * a + 1][3]);
    const long pbA = mk64(p0 & amA, p1 & amA);
#pragma unroll
    for (int dt = 0; dt < 4; ++dt)
      st.o[dt] = mfma8(a == 0 ? mk64(fa.v[dt].x, fa.v[dt].y) : mk64(fa.v[dt].z, fa.v[dt].w), pbA, st.o[dt]);
    if (useB) {
      const long pbB = mk64(p0 & amB, p1 & amB);
#pragma unroll
      for (int dt = 0; dt < 4; ++dt)
        st.o[dt] = mfma8(a == 0 ? mk64(fb.v[dt].x, fb.v[dt].y) : mk64(fb.v[dt].z, fb.v[dt].w), pbB, st.o[dt]);
    }
  }
}

DI void sm_init(SMState& st) {
  st.m = -1e30f;
  st.l = 0.f;
#pragma unroll
  for (int dt = 0; dt < 4; ++dt) st.o[dt] = f32x4{0.f, 0.f, 0.f, 0.f};
}
DI float sm_invl(const SMState& st) {
  float L = st.l + __shfl_xor(st.l, 16);
  L += __shfl_xor(L, 32);
  return L > 0.f ? 1.f / L : 0.f;
}

DI void hg_scan(const int tid, const float* __restrict__ logf, int row0, int h, float* segs  , float (&lf)[16], float (&bb)[16],
                float& total) {
  const int k = tid & 127, seg = tid >> 7;
  float run = 0.f;
#pragma unroll
  for (int i = 0; i < 16; ++i) {
    lf[i] = logf[(size_t)(row0 + seg * 16 + i) * 1024 + h * 128 + k];
    run += lf[i];
    bb[i] = run;
  }
  segs[seg * 128 + k] = run;
  __syncthreads();
  float off = 0.f, tot = 0.f;
#pragma unroll
  for (int s2 = 0; s2 < 4; ++s2) {
    const float v = segs[s2 * 128 + k];
    if (s2 < seg) off += v;
    tot += v;
  }
#pragma unroll
  for (int i = 0; i < 16; ++i) bb[i] += off;
  total = tot;
}

#define wt_nsa_in ((u16*)(p.ws + OFF_WT_NSA_IN))
#define wt_hg_in ((u16*)(p.ws + OFF_WT_HG_IN))
#define wt_nsa_out ((u16*)(p.ws + OFF_WT_NSA_OUT))
#define wt_hg_out ((u16*)(p.ws + OFF_WT_HG_OUT))
#define wt_k1 ((u16*)(p.ws + OFF_WT_K1))
#define wt_v1 ((u16*)(p.ws + OFF_WT_V1))
#define rope ((float2*)(p.ws + OFF_ROPE))
#define bias1 ((float*)(p.ws + OFF_MISC))
#define lbv ((float*)(p.ws + OFF_MISC) + 512)
#define Hb ((u16*)(p.ws + OFF_H))
#define Qb ((u16*)(p.ws + OFF_Q))
#define KCb ((u16*)(p.ws + OFF_KC))
#define VCb ((u16*)(p.ws + OFF_VC))
#define KSb ((u16*)(p.ws + OFF_KS))
#define VSTb ((u16*)(p.ws + OFF_VST))
#define KWb ((u16*)(p.ws + OFF_KW))
#define VWTb ((u16*)(p.ws + OFF_VWT))
#define SZb ((u16*)(p.ws + OFF_SZ))
#define GATESb ((float*)(p.ws + OFF_GATES))
#define HIDb ((u16*)(p.ws + OFF_HID))
#define KCMPb ((u16*)(p.ws + OFF_KCMP))
#define VCMPTb ((u16*)(p.ws + OFF_VCMPT))
#define Ob ((u16*)(p.ws + OFF_O))
#define STb ((u16*)(p.ws + OFF_STATES))
#define QHb ((u16*)(p.ws + OFF_QH))
#define LOGFb ((float*)(p.ws + OFF_LOGF))
#define VHb ((u16*)(p.ws + OFF_VH))
#define SZHb ((u16*)(p.ws + OFF_SZH))
#define DCb ((float*)(p.ws + OFF_DC))

#define XB_TMO      128
#define XB_XCNT(j)  (256  + 64 * (j))
#define XB_XSUB(j)  (1280 + 64 * (j))
#define XB_XGEN(j)  (2304 + 64 * (j))
#define XB_TOP      3328
#define XB_TOPGEN   3392
#define XCD_BAR_WORDS 3456
#define XB_SPIN_CAP (1u << 18)
#define LAS __attribute__((address_space(3)))

__device__ __forceinline__ unsigned xb_ld(unsigned* p)              { return __hip_atomic_load(p, __ATOMIC_RELAXED, __HIP_MEMORY_SCOPE_AGENT); }
__device__ __forceinline__ unsigned xb_add(unsigned* p, unsigned v) { return __hip_atomic_fetch_add(p, v, __ATOMIC_RELAXED, __HIP_MEMORY_SCOPE_AGENT); }
__device__ __forceinline__ unsigned xb_xcc_id() { return (unsigned)__builtin_amdgcn_s_getreg((3 << 11) | 20) & 0xFu; }
#define XB_SPIN(cond, bar) do { unsigned _sp = 0; while (cond) { __builtin_amdgcn_s_sleep(1); \
    if ((++_sp & 255u) == 0u) { if (xb_ld(&(bar)[XB_TMO])) break; if (_sp > XB_SPIN_CAP) { atomicAdd(&(bar)[XB_TMO], 1u); break; } } } } while (0)

struct XcdBarrier {
    unsigned* bar; unsigned x;
    volatile LAS unsigned* st;
};

__device__ __forceinline__ XcdBarrier xcd_barrier_post(unsigned* bar, volatile LAS unsigned* st) {
    XcdBarrier b; b.bar = bar; b.x = xb_xcc_id(); b.st = st;
    if (threadIdx.x == 0) (void)xb_add(&bar[XB_XCNT(b.x)], 1u);
    return b;
}
__device__ __forceinline__ void xcd_barrier_complete(unsigned* bar, unsigned x, unsigned& nloc, unsigned& nx) {
    const unsigned G = gridDim.x * gridDim.y * gridDim.z;
    unsigned sum, cnt, mine, sp = 0u;
    for (;;) {
        sum = 0u; cnt = 0u; mine = 0u;
#pragma unroll
        for (unsigned j = 0; j < 16; ++j) { const unsigned c = xb_ld(&bar[XB_XCNT(j)]); sum += c; cnt += (c > 0u) ? 1u : 0u; mine = (j == x) ? c : mine; }
        if (sum == G) break;
        __builtin_amdgcn_s_sleep(1);
        if ((++sp & 255u) == 0u) { if (xb_ld(&bar[XB_TMO])) break; if (sp > XB_SPIN_CAP) { atomicAdd(&bar[XB_TMO], 1u); break; } }
    }
    nloc = mine > 0u ? mine : 1u; nx = cnt > 0u ? cnt : 1u;
}

__device__ __forceinline__ void xcd_barrier(const XcdBarrier& b) {
    asm volatile("s_waitcnt vmcnt(0)" ::: "memory");
    __syncthreads();
    if (threadIdx.x == 0) {
        unsigned* bar = b.bar;
        __builtin_amdgcn_s_waitcnt(0);
        unsigned nloc = b.st[0], nx = b.st[1];
        if (nloc == 0u) { xcd_barrier_complete(bar, b.x, nloc, nx); b.st[0] = nloc; b.st[1] = nx; }
        const unsigned old = xb_add(&bar[XB_XSUB(b.x)], 1u);
        const unsigned gen = old / nloc;
        if (old + 1u == (gen + 1u) * nloc) {
            __builtin_amdgcn_fence(__ATOMIC_RELEASE, "agent");
            asm volatile("s_waitcnt vmcnt(0)" ::: "memory");
            const unsigned og = xb_add(&bar[XB_TOP], 1u);
            const unsigned tg = og / nx;
            if (og + 1u == (tg + 1u) * nx) xb_add(&bar[XB_TOPGEN], 1u);
            else XB_SPIN(xb_ld(&bar[XB_TOPGEN]) == tg, bar);
            __builtin_amdgcn_fence(__ATOMIC_ACQUIRE, "agent");
            xb_add(&bar[XB_XGEN(b.x)], 1u);
            asm volatile("s_waitcnt vmcnt(0)" ::: "memory");
        } else {
            XB_SPIN(xb_ld(&bar[XB_XGEN(b.x)]) == gen, bar);
            __builtin_amdgcn_fence(__ATOMIC_ACQUIRE, "agent");
            asm volatile("s_waitcnt vmcnt(0)" ::: "memory");
        }
    }
    __syncthreads();
}


DI void gbar(unsigned* ctr, unsigned target) {
  asm volatile("s_waitcnt vmcnt(0) lgkmcnt(0)" ::: "memory");
  __syncthreads();
  if (threadIdx.x == 0) {
    __builtin_amdgcn_fence(__ATOMIC_RELEASE, "agent");
    asm volatile("s_waitcnt vmcnt(0)" ::: "memory");
    __hip_atomic_fetch_add(ctr, 1u, __ATOMIC_RELAXED, __HIP_MEMORY_SCOPE_AGENT);
    while (__hip_atomic_load(ctr, __ATOMIC_RELAXED, __HIP_MEMORY_SCOPE_AGENT) < target) __builtin_amdgcn_s_sleep(2);
  }
  __syncthreads();
  __builtin_amdgcn_fence(__ATOMIC_ACQUIRE, "agent");
  asm volatile("s_waitcnt vmcnt(0)" ::: "memory");
}

#define FOR_TILES_XCD(NT_, MT_VAR, NT_VAR)                                                                   \
  for (int lt_ = ((gridDim.x & 7) == 0 ? (int)(blockIdx.x >> 3) : (int)blockIdx.x), MT_VAR = 0, NT_VAR = 0; \
       lt_ < ((gridDim.x & 7) == 0 ? 16 * (NT_) : 128 * (NT_)) &&                                           \
       (MT_VAR = ((gridDim.x & 7) == 0 ? (int)(blockIdx.x & 7) * 16 : 0) + lt_ / (NT_), NT_VAR = lt_ % (NT_), true); \
       lt_ += ((gridDim.x & 7) == 0 ? (int)(gridDim.x >> 3) : (int)gridDim.x))

__global__ void __launch_bounds__(NTHR) mega(Params p) {
  char* const smem = dyn_lds;
  cg::grid_group grid = cg::this_grid();
  int tid, lane, wave, gw, gt;
  const int nw = gridDim.x * (NTHR / 64), ngt = gridDim.x * NTHR;
#define REFRESH()                                  \
  {                                                \
    tid = threadIdx.x;                             \
    asm volatile("" : "+v"(tid));                  \
    lane = tid & 63;                               \
    wave = tid >> 6;                               \
    gw = blockIdx.x * (NTHR / 64) + wave;          \
    gt = blockIdx.x * NTHR + tid;                  \
  }
  unsigned* bar_ctr = (unsigned*)(p.ws + OFF_MISC + 16384);
  __shared__ uint4 xb_words;
  if (threadIdx.x == 0) xb_words = make_uint4(0u, 0u, 0u, 0u);
  __syncthreads();
  const XcdBarrier xb = xcd_barrier_post(bar_ctr, (volatile LAS unsigned*)&xb_words);
  REFRESH();

  PH(0) {
  REFRESH();
  transpose_w(smem, tid, p.nsa_w_in, 3632, wt_nsa_in, 1024, NSA_NP, [](int n) {
    return n < 2560 ? n : (n < 3584 ? n + 48 : (n < 3632 ? n - 1024 : -1));
  });
  transpose_w(smem, tid, p.hg_w_in, 4096, wt_hg_in, 1024, 4096, [](int n) { return n; });
  transpose_w(smem, tid, p.nsa_w_out, 1024, wt_nsa_out, 1024, 1024, [](int n) { return n; });
  transpose_w(smem, tid, p.hg_w_out, 1024, wt_hg_out, 1024, 1024, [](int n) { return n; });
  transpose_w(smem, tid, p.wk1, 256, wt_k1, 2048, 256, [](int n) { return n; });
  transpose_w(smem, tid, p.wv1, 256, wt_v1, 2048, 256, [](int n) { return n; });
  for (int e = gt; e < SEQ * 32; e += ngt) {
    const int pos = e >> 5, d = e & 31;
    double inv = 1.0;
    for (int i = 0; i < d; ++i) inv *= 0.7498942093324559;
    const float invf = (float)inv;
    const float ang = (float)pos * invf;
    float cs, sn;
    sincos_reduced((double)ang, cs, sn);
    rope[e] = make_float2(cs, sn);
  }
  for (int o = gw; o < 512; o += nw) {
    const int which = o >> 8, j = o & 255;
    const float* pe = which ? p.pe_v : p.pe_k;
    const float* w1 = which ? p.wv1 : p.wk1;
    float acc = 0.f;
    for (int k = lane; k < 2048; k += 64) acc += pe[k] * w1[(size_t)k * 256 + j];
    acc = wave_sum(acc);
    if (lane == 0) bias1[o] = acc;
  }
  for (int k = gt; k < 1024; k += ngt) {
    const float l0 = p.lb_logits[k], l1 = p.lb_logits[1024 + k];
    const float mx = fmaxf(l0, l1);
    const float e0 = __expf(l0 - mx), e1 = __expf(l1 - mx);
    const float p0 = e0 / (e0 + e1), p1 = e1 / (e0 + e1);
    lbv[k] = (p0 + p1) - p0;
  }
  rmsnorm_to_bf16(p.x, p.norm_w, Hb, gw, nw, lane);
  }
  if (p.ws == nullptr) grid.sync();
  xcd_barrier(xb);

  PH(1) {
  REFRESH();
  {
    auto afn = [&](int row, int k) { return Hb + (size_t)row * 1024 + k; };
    const int lane_ = lane;
    auto epi = [&](f32x16(&accf)[2][4], int mb, int nb, auto nio_) {
      constexpr int NIO = decltype(nio_)::value;
      int lane = lane_;
      asm volatile("" : "+v"(lane));
      const int l31 = lane & 31, lh = lane >> 5;
      const int b = mb >> 14;
      char* wlds = smem + wave * 8192;
      const bool is_q = nb < 1024;
      const bool is_ks = nb >= 1536 && nb < 1792;
      const bool is_kw = nb >= 2048 && nb < 2304;
      if (is_q || is_ks || is_kw) {
        const float scale = is_q ? 0.18033688011112042f : 1.f;
        const float2* ropep = rope + ((mb & (SEQ - 1)) + lh * 4) * 32 + l31;
        auto vf = [&](int mi, int i) {
          const float2 cs = ropep[(mi * 32 + (i >> 2) * 8 + (i & 3)) * 32];
          const float x1 = accf[mi][NIO + 0][i], x2 = accf[mi][NIO + 1][i];
          return F2{(x1 * cs.x - x2 * cs.y) * scale, (x2 * cs.x + x1 * cs.y) * scale};
        };
        if (is_q) {
          stage_out<0>(wlds, lane, vf, Qb + (size_t)mb * 1024 + nb, 1024);
        } else {
          const int g = ((nb - (is_ks ? 1536 : 2048)) >> 6);
          const int blk = (mb & (SEQ - 1)) >> 6;
          if (is_ks) stage_out<1, true>(wlds, lane, vf, (u16*)((char*)KSb + ((size_t)(b * 4 + g) * 256 + blk) * 4096), 0);
          else stage_out<1>(wlds, lane, vf, KWb + ((size_t)(b * 4 + g) * 256 + blk) * 4096, 0);
        }
      } else if (nb >= 1024 && nb < 1536) {
        auto vf = [&](int mi, int i) { return F2{accf[mi][NIO + 0][i], accf[mi][NIO + 1][i]}; };
        stage_out<0>(wlds, lane, vf, (nb < 1280 ? KCb : VCb) + (size_t)mb * 256 + (nb & 255), 256);
      } else if ((nb >= 1792 && nb < 2048) || (nb >= 2304 && nb < 2560)) {
        const bool is_vs = nb < 2048;
        const int g = (nb - (is_vs ? 1792 : 2304)) >> 6;
        const int blk = (mb & (SEQ - 1)) >> 6;
        auto vf = [&](int mi, int i) { return F2{accf[mi][NIO + 0][i], accf[mi][NIO + 1][i]}; };
        if (is_vs) stage_out<2, true>(wlds, lane, vf, (u16*)((char*)VSTb + ((size_t)((b * 4 + g) * 256 + blk)) * 4096), 0);
        else stage_out<2>(wlds, lane, vf, VWTb + ((size_t)((b * 4 + g) * 256 + blk)) * 4096, 0);
      } else if (nb >= 2560 && nb < 3584) {
        auto vf = [&](int mi, int i) { return F2{siluf_(accf[mi][NIO + 0][i]), siluf_(accf[mi][NIO + 1][i])}; };
        stage_out<0>(wlds, lane, vf, SZb + (size_t)mb * 1024 + (nb - 2560), 1024);
      } else {
#pragma unroll
        for (int mi = 0; mi < 2; ++mi)
#pragma unroll
          for (int ni = 0; ni < 2; ++ni) {
            const int col = nb - 3584 + ni * 32 + l31;
            if (col < 48) {
#pragma unroll
              for (int i = 0; i < 16; ++i) {
                const int row = mb + mi * 32 + (i >> 2) * 8 + lh * 4 + (i & 3);
                GATESb[(size_t)row * 48 + col] = sigmoidf_(accf[mi][NIO + ni][i]);
              }
            }
          }
      }
    };
    const int NNT = NSA_NP / 256;
    FOR_TILES_XCD(NNT, mt, nt) gemm_tile256(smem, tid, afn, wt_nsa_in, 1024, mt * 256, nt * 256, epi);
  }
  }
  xcd_barrier(xb);

  PH(2) {
  REFRESH();
  {
    for (int t = blockIdx.x; t < 64; t += gridDim.x) {
      const int which = t >> 5, mt = t & 31;
      const u16* src = which ? VCb : KCb;
      auto afn = [&](int row, int k) {
        const int b = row >> 12, g = (row >> 10) & 3;
        int n = row & 1023;
        n = n > 1022 ? 1022 : n;
        return src + (size_t)(b * SEQ + 16 * n + (k >> 6)) * 256 + g * 64 + (k & 63);
      };
      const int lane_ = lane;
    auto epi = [&](f32x16(&accf)[2][4], int mb, int nb, auto nio_) {
        constexpr int NIO = decltype(nio_)::value;
        int lane = lane_;
        asm volatile("" : "+v"(lane));
        const int l31 = lane & 31;
        const float b0 = bias1[which * 256 + nb + l31], b1 = bias1[which * 256 + nb + 32 + l31];
        auto vf = [&](int mi, int i) { return F2{siluf_(accf[mi][NIO + 0][i] + b0), siluf_(accf[mi][NIO + 1][i] + b1)}; };
        stage_out<0>(smem + wave * 8192, lane, vf, HIDb + ((size_t)which * 8192 + mb) * 256 + nb, 256);
      };
      gemm_tile256(smem, tid, afn, which ? wt_v1 : wt_k1, 2048, mt * 256, 0, epi);
    }
  }
  }
  xcd_barrier(xb);

  PH(3) {
  REFRESH();
  float* w2k = (float*)smem;
  float* w2v = (float*)(smem + 65536);
  for (int i = tid; i < 4096; i += NTHR) {
    ((float4*)w2k)[i] = ((const float4*)p.wk2)[i];
    ((float4*)w2v)[i] = ((const float4*)p.wv2)[i];
  }
  __syncthreads();
  for (int e = gt; e < 8192 * 32; e += ngt) {
    const int m = e >> 5, d = e & 31;
    float k1 = 0.f, k2 = 0.f, v1 = 0.f, v2 = 0.f;
    const u16* hk = HIDb + (size_t)m * 256;
    const u16* hv = HIDb + ((size_t)8192 + m) * 256;
    for (int j0 = 0; j0 < 256; j0 += 8) {
      const uint4 uk = *(const uint4*)(hk + j0);
      const uint4 uv = *(const uint4*)(hv + j0);
      const unsigned ak[4] = {uk.x, uk.y, uk.z, uk.w};
      const unsigned av[4] = {uv.x, uv.y, uv.z, uv.w};
#pragma unroll
      for (int jj = 0; jj < 8; ++jj) {
        const float fk = (jj & 1) ? bfhi(ak[jj >> 1]) : bflo(ak[jj >> 1]);
        const float fv = (jj & 1) ? bfhi(av[jj >> 1]) : bflo(av[jj >> 1]);
        const int j = j0 + jj;
        k1 += fk * w2k[j * 64 + d];
        k2 += fk * w2k[j * 64 + 32 + d];
        v1 += fv * w2v[j * 64 + d];
        v2 += fv * w2v[j * 64 + 32 + d];
      }
    }
    const int n = m & 1023, bg = m >> 10;
    int pos = 16 * n + 31;
    pos = pos > SEQ - 1 ? SEQ - 1 : pos;
    const float2 cs = rope[pos * 32 + d];
    u16* kt_ = KCMPb + (size_t)(bg * 16 + (n >> 6)) * 4096;
    kt_[kfrag_off(n & 63, d)] = f2bf(k1 * cs.x - k2 * cs.y);
    kt_[kfrag_off(n & 63, 32 + d)] = f2bf(k2 * cs.x + k1 * cs.y);
    u16* vt = VCMPTb + (size_t)(bg * 16 + (n >> 6)) * 4096;
    vt[vfrag_off(d, n & 63)] = f2bf(v1);
    vt[vfrag_off(d + 32, n & 63)] = f2bf(v2);
  }
  }
  xcd_barrier(xb);

  PH(4) {
  REFRESH();
  {
    const int c = lane & 15, q4 = lane >> 4, tokc = c >> 2, r = c & 3;
    float* imp = (float*)(smem + wave * 6144);
    unsigned* keys_l = (unsigned*)(smem + wave * 6144 + 4096);
    int* sel_l = (int*)(smem + wave * 6144 + 5120);
    const int ngrp = gridDim.x < 8 ? gridDim.x : 8;
    const int grp = blockIdx.x % ngrp, lb = blockIdx.x / ngrp;
    const int nbg = (gridDim.x - grp + ngrp - 1) / ngrp;
    for (int bg = grp; bg < 8; bg += ngrp)
    for (int t4 = lb * (NTHR / 64) + wave; t4 < 4096; t4 += nbg * (NTHR / 64)) {
      const int b = bg >> 2, g = bg & 3;
      const int tok0 = t4 * 4, t_c = tok0 + tokc, head = g * 4 + r;
      const size_t trow = (size_t)(b * SEQ + t_c);
      bf16x8 qf[2];
      {
        const u16* qp = Qb + trow * 1024 + head * 64 + q4 * 8;
        qf[0] = ld8(qp);
        qf[1] = ld8(qp + 32);
      }
      KVFrag fa, fb;
      f32x4 oc[4];
      {
        const int nmax_c = (t_c >= 31) ? ((t_c - 31) >> 4) : -1;
        const int nmax_w = (tok0 + 3 >= 31) ? ((tok0 + 3 - 31) >> 4) : -1;
        const int nkt = (nmax_w >= 0) ? (nmax_w >> 6) + 1 : 0;
        const u16* kcb = KCMPb + (size_t)bg * 1024 * 64;
        const u16* vcb = VCMPTb + (size_t)bg * 16 * 4096;
        float m_l = -1e30f, l_l = 0.f;
        const int nmax_0 = (tok0 >= 31) ? ((tok0 - 31) >> 4) : -1;
        auto pass1 = [&](const KVFrag& f, int kt) {
          f32x4 s[4];
          qk_scores(s, f, qf);
          const bool full = kt * 64 + 63 <= nmax_0;
          if (!full) {
#pragma unroll
            for (int st = 0; st < 4; ++st)
#pragma unroll
              for (int i = 0; i < 4; ++i) {
                const int n = kt * 64 + st * 16 + q4 * 4 + i;
                s[st][i] = n <= nmax_c ? s[st][i] : -1e30f;
              }
          }
          float mt = -1e30f;
#pragma unroll
          for (int st = 0; st < 4; ++st) mt = fmaxf(mt, fmaxf(fmaxf(s[st][0], s[st][1]), fmaxf(s[st][2], s[st][3])));
          const float mn = fmaxf(m_l, mt);
          float a = 0.f;
          if (full) {
#pragma unroll
            for (int st = 0; st < 4; ++st)
#pragma unroll
              for (int i = 0; i < 4; ++i) a += exp2f_(s[st][i] - mn);
          } else {
#pragma unroll
            for (int st = 0; st < 4; ++st)
#pragma unroll
              for (int i = 0; i < 4; ++i) a += s[st][i] > -1e29f ? exp2f_(s[st][i] - mn) : 0.f;
          }
          l_l = l_l * exp2f_(m_l - mn) + a;
          m_l = mn;
        };
        if (nkt > 0) {
          load_k(fa, kcb, c, q4);
#pragma unroll 1
          for (int kt = 0; kt < nkt; kt += 2) {
            const int k1 = kt + 1 < nkt ? kt + 1 : nkt - 1;
            load_k(fb, kcb + k1 * 4096, c, q4);
            pass1(fa, kt);
            const int k2 = kt + 2 < nkt ? kt + 2 : nkt - 1;
            load_k(fa, kcb + k2 * 4096, c, q4);
            if (kt + 1 < nkt) pass1(fb, kt + 1);
          }
        }
        float M = fmaxf(m_l, __shfl_xor(m_l, 16));
        M = fmaxf(M, __shfl_xor(M, 32));
        const float lsc = l_l * exp2f_(m_l - M);
        float L = lsc + __shfl_xor(lsc, 16);
        L += __shfl_xor(L, 32);
        const float ML = L > 0.f ? M + __log2f(L) : 1e30f;
#pragma unroll
        for (int i = 0; i < 16; ++i) imp[lane + 64 * i] = 0.f;
#pragma unroll
        for (int dt = 0; dt < 4; ++dt) oc[dt] = f32x4{0.f, 0.f, 0.f, 0.f};
        auto pass2 = [&](const KVFrag& f, int kt) {
          bf16x8 vv[8];
          {
            const u16* vp = vcb + kt * 4096 + (q4 * 16 + c) * 8;
#pragma unroll
            for (int fr = 0; fr < 8; ++fr) vv[fr] = ld8(vp + fr * 512);
          }
          f32x4 s[4];
          qk_scores(s, f, qf);
          const bool full2 = kt * 64 + 63 <= nmax_0;
#pragma unroll
          for (int st = 0; st < 4; ++st) {
            if (full2) {
#pragma unroll
              for (int i = 0; i < 4; ++i) s[st][i] = exp2f_(s[st][i] - ML);
            } else {
#pragma unroll
              for (int i = 0; i < 4; ++i) {
                const int n = kt * 64 + st * 16 + q4 * 4 + i;
                s[st][i] = n <= nmax_c ? exp2f_(s[st][i] - ML) : 0.f;
              }
            }
            float s4 = (s[st][0] + s[st][1]) + (s[st][2] + s[st][3]);
            float lst = s[st][3];
            s4 += dpp_xor1(s4);
            s4 += dpp_xor2(s4);
            lst += dpp_xor1(lst);
            lst += dpp_xor2(lst);
            const int j = kt * 16 + st * 4 + q4;
            if (r == 0) {
              atomicAdd(&imp[tokc * 256 + j], s4);
              if (j + 1 < 256) atomicAdd(&imp[tokc * 256 + j + 1], lst);
            }
          }
#pragma unroll
          for (int a = 0; a < 2; ++a) {
            const bf16x8 pb = pack8(s[2 * a], s[2 * a + 1]);
#pragma unroll
            for (int dt = 0; dt < 4; ++dt) oc[dt] = mfma16(vv[a * 4 + dt], pb, oc[dt]);
          }
        };
        if (nkt > 0) {
          load_k(fa, kcb, c, q4);
#pragma unroll 1
          for (int kt = 0; kt < nkt; kt += 2) {
            const int k1 = kt + 1 < nkt ? kt + 1 : nkt - 1;
            load_k(fb, kcb + k1 * 4096, c, q4);
            pass2(fa, kt);
            const int k2 = kt + 2 < nkt ? kt + 2 : nkt - 1;
            load_k(fa, kcb + k2 * 4096, c, q4);
            if (kt + 1 < nkt) pass2(fb, kt + 1);
          }
        }
        const float g0 = GATESb[trow * 48 + head * 3 + 0];
#pragma unroll
        for (int dt = 0; dt < 4; ++dt) oc[dt] *= g0;
      }
      __builtin_amdgcn_wave_barrier();
      {
        const int cur = tok0 >> 6;
        unsigned my[4][4];
#pragma unroll
        for (int tk = 0; tk < 4; ++tk)
#pragma unroll
          for (int cc = 0; cc < 4; ++cc) {
            const int j = lane + 64 * cc;
            const bool forced = (j == 0) || (j == cur) || (j == cur - 1);
            const unsigned fb_ = __float_as_uint(imp[tk * 256 + j]) & 0xffffff00u;
            my[tk][cc] = (forced ? 0xffffff00u : (j <= cur ? fb_ : 0u)) | (unsigned)(255 - j);
          }
        unsigned T[4] = {0u, 0u, 0u, 0u};
#pragma unroll 1
        for (int bit = 31; bit >= 0; --bit) {
#pragma unroll
          for (int tk = 0; tk < 4; ++tk) {
            const unsigned cand = T[tk] | (1u << bit);
            const int n_ge = __popcll(__ballot(my[tk][0] >= cand)) + __popcll(__ballot(my[tk][1] >= cand)) +
                             __popcll(__ballot(my[tk][2] >= cand)) + __popcll(__ballot(my[tk][3] >= cand));
            T[tk] = n_ge >= 16 ? cand : T[tk];
          }
        }
#pragma unroll
        for (int tk = 0; tk < 4; ++tk) {
          int base = 0;
#pragma unroll
          for (int cc = 0; cc < 4; ++cc) {
            const int jq = lane + 64 * cc;
            const bool selq = my[tk][cc] >= T[tk] && !((jq == 0) || (jq == cur) || (jq == cur - 1));
            const unsigned long long mask = __ballot(selq);
            const int pos = base + __popcll(mask & ((1ull << lane) - 1ull));
            if (selq) sel_l[tk * 16 + pos] = lane + 64 * cc;
            base += __popcll(mask);
          }
        }
        __builtin_amdgcn_wave_barrier();
      }
      float* stash = imp;
#pragma unroll
      for (int dt = 0; dt < 4; ++dt)
#pragma unroll
        for (int i = 0; i < 4; ++i) stash[(dt * 4 + i) * 64 + lane] = oc[dt][i];
      {
        SMState ss;
        sm_init(ss);
        long q8[2];
#pragma unroll
        for (int ks = 0; ks < 2; ++ks) {
          const uint4 u = __builtin_bit_cast(uint4, qf[ks]);
          const unsigned lo = cvt4_fp8(bflo(u.x) * 8.f, bfhi(u.x) * 8.f, bflo(u.y) * 8.f, bfhi(u.y) * 8.f);
          const unsigned hi = cvt4_fp8(bflo(u.z) * 8.f, bfhi(u.z) * 8.f, bflo(u.w) * 8.f, bfhi(u.w) * 8.f);
          q8[ks] = mk64(lo, hi);
        }
        const char* ksb = (const char*)KSb + (size_t)bg * 256 * 4096;
        const char* vsb = (const char*)VSTb + (size_t)bg * 256 * 4096;
        const int curw = tok0 >> 6;
        const int nf = curw >= 2 ? 3 : curw + 1;
        const int len = 16 - nf;
        const int total = nf + 2 * len;
        auto entry = [&](int x, int& blkB, int& pp) {
          x = x < total ? x : total - 1;
          if (x < nf) {
            pp = -1;
            const int fb_ = x == 0 ? 0 : (x == nf - 1 ? curw : curw - 1);
            blkB = fb_;
            return fb_;
          }
          const int e = x - nf;
          pp = e / len;
          const int it = e - pp * len;
          blkB = __builtin_amdgcn_readfirstlane(sel_l[(2 * pp + 1) * 16 + it]);
          return __builtin_amdgcn_readfirstlane(sel_l[(2 * pp) * 16 + it]);
        };
        auto visit = [&](const KV8& fa_, const KV8& fb_, int blkA, int blkB, int pp) {
          if (pp < 0) {
            if (blkA < curw) attn_pair8<false>(ss, fa_, fb_, q8, blkA * 64, t_c, true, true, false, q4);
            else attn_pair8<true>(ss, fa_, fb_, q8, blkA * 64, t_c, true, true, false, q4);
          } else {
            const bool laneA = tokc == 2 * pp;
            const bool act = (laneA && blkA < curw) || (tokc == 2 * pp + 1 && blkB < curw);
            attn_pair8<false>(ss, fa_, fb_, q8, 0, t_c, laneA, act, true, q4);
          }
        };
        KV8 ga0, gb0, ga1, gb1;
        int pA0, pB0, pp0, pA1, pB1, pp1;
        pA0 = entry(0, pB0, pp0);
        load_kv8(ga0, ksb + pA0 * 4096, vsb + pA0 * 4096, lane);
        load_kv8(gb0, ksb + pB0 * 4096, vsb + pB0 * 4096, lane);
#pragma unroll 1
        for (int x = 0; x < total; x += 2) {
          pA1 = entry(x + 1, pB1, pp1);
          load_kv8(ga1, ksb + pA1 * 4096, vsb + pA1 * 4096, lane);
          load_kv8(gb1, ksb + pB1 * 4096, vsb + pB1 * 4096, lane);
          visit(ga0, gb0, pA0, pB0, pp0);
          pA0 = entry(x + 2, pB0, pp0);
          load_kv8(ga0, ksb + pA0 * 4096, vsb + pA0 * 4096, lane);
          load_kv8(gb0, ksb + pB0 * 4096, vsb + pB0 * 4096, lane);
          if (x + 1 < total) visit(ga1, gb1, pA1, pB1, pp1);
        }
        const float inv = sm_invl(ss) * GATESb[trow * 48 + head * 3 + 1];
#pragma unroll
        for (int dt = 0; dt < 4; ++dt)
#pragma unroll
          for (int i = 0; i < 4; ++i) stash[(dt * 4 + i) * 64 + lane] += ss.o[dt][i] * inv;
      }
      {
        {
          const u16* qp = Qb + trow * 1024 + head * 64 + q4 * 8;
          qf[0] = ld8(qp);
          qf[1] = ld8(qp + 32);
          asm volatile("" : "+v"(qf[0]), "+v"(qf[1]));
        }
        SMState sw;
        sm_init(sw);
        const u16* kwb = KWb + (size_t)bg * SEQ * 64;
        const u16* vwb = VWTb + (size_t)bg * 256 * 4096;
        const int lo = tok0 - 511 > 0 ? tok0 - 511 : 0;
        const int kt0 = lo >> 6, kt1 = (tok0 + 3) >> 6;
        load_k(fa, kwb + kt0 * 4096, c, q4);
        load_v(fa, vwb + kt0 * 4096, c, q4);
#pragma unroll 1
        for (int kt = kt0; kt <= kt1; kt += 2) {
          const int k1 = kt + 1 <= kt1 ? kt + 1 : kt1;
          load_k(fb, kwb + k1 * 4096, c, q4);
          load_v(fb, vwb + k1 * 4096, c, q4);
          if (kt * 64 >= tok0 + 3 - 511 && kt * 64 + 63 <= tok0) attn_compute<false>(sw, fa, qf, kt * 64, t_c - 511, t_c, true, q4);
          else attn_compute<true>(sw, fa, qf, kt * 64, t_c - 511, t_c, true, q4);
          const int k2 = kt + 2 <= kt1 ? kt + 2 : kt1;
          load_k(fa, kwb + k2 * 4096, c, q4);
          load_v(fa, vwb + k2 * 4096, c, q4);
          if (kt + 1 <= kt1) {
            if ((kt + 1) * 64 >= tok0 + 3 - 511 && (kt + 1) * 64 + 63 <= tok0) attn_compute<false>(sw, fb, qf, (kt + 1) * 64, t_c - 511, t_c, true, q4);
            else attn_compute<true>(sw, fb, qf, (kt + 1) * 64, t_c - 511, t_c, true, q4);
          }
        }
        const float inv = sm_invl(sw) * GATESb[trow * 48 + head * 3 + 2];
#pragma unroll
        for (int dt = 0; dt < 4; ++dt)
#pragma unroll
          for (int i = 0; i < 4; ++i) oc[dt][i] = stash[(dt * 4 + i) * 64 + lane] + sw.o[dt][i] * inv;
      }
      __builtin_amdgcn_wave_barrier();
#pragma unroll
      for (int dt = 0; dt < 4; ++dt) {
        const size_t idx = trow * 1024 + head * 64 + dt * 16 + q4 * 4;
        const uint2 zz = *(const uint2*)(SZb + idx);
        uint2 o;
        o.x = pack2(oc[dt][0] * bflo(zz.x), oc[dt][1] * bfhi(zz.x));
        o.y = pack2(oc[dt][2] * bflo(zz.y), oc[dt][3] * bfhi(zz.y));
        *(uint2*)(Ob + idx) = o;
      }
    }
  }
}
  xcd_barrier(xb);

  PH(5) {
  REFRESH();
  {
    auto afn = [&](int row, int k) { return Ob + (size_t)row * 1024 + k; };
    const int lane_ = lane;
    auto epi = [&](f32x16(&accf)[2][4], int mb, int nb, auto nio_) {
      constexpr int NIO = decltype(nio_)::value;
      int lane = lane_;
      asm volatile("" : "+v"(lane));
      stage_add_f32<NIO>(smem + wave * 16384, lane, accf, p.x + (size_t)mb * 1024 + nb, p.out + (size_t)mb * 1024 + nb, 1024);
    };
    FOR_TILES_XCD(4, mt, nt) gemm_tile256(smem, tid, afn, wt_nsa_out, 1024, mt * 256, nt * 256, epi);
  }
  }
  xcd_barrier(xb);

  PH(6) {
  REFRESH();
  rmsnorm_to_bf16(p.out, p.norm_w + 1024, Hb, gw, nw, lane);
  }
  xcd_barrier(xb);

  PH(7) {
  REFRESH();
  {
    auto afn = [&](int row, int k) { return Hb + (size_t)row * 1024 + k; };
    const int lane_ = lane;
    auto epi = [&](f32x16(&accf)[2][4], int mb, int nb, auto nio_) {
      constexpr int NIO = decltype(nio_)::value;
      int lane = lane_;
      asm volatile("" : "+v"(lane));
      const int l31 = lane & 31, lh = lane >> 5;
      const int sect = nb >> 10, cb = nb & 1023;
      char* wlds = smem + wave * 8192;
      if (sect == 1) {
#pragma unroll
        for (int mi = 0; mi < 2; ++mi)
#pragma unroll
          for (int ni = 0; ni < 2; ++ni) {
            const int col = cb + ni * 32 + l31;
            const float lb = lbv[col];
#pragma unroll
            for (int i = 0; i < 16; ++i) {
              const int row = mb + mi * 32 + (i >> 2) * 8 + lh * 4 + (i & 3);
              float xv_ = accf[mi][NIO + ni][i];
              asm volatile("" : "+v"(xv_));
              LOGFb[(size_t)row * 1024 + col] = __logf(lb + (1.f - lb) * sigmoidf_(xv_));
              if ((i & 3) == 3) asm volatile("" ::: "memory");
            }
          }
      } else if (sect == 2) {
        auto vf = [&](int mi, int i) { return F2{accf[mi][NIO + 0][i], accf[mi][NIO + 1][i]}; };
        stage_out<0>(wlds, lane, vf, VHb + (size_t)mb * 1024 + cb, 1024);
      } else {
        auto vf = [&](int mi, int i) { return F2{siluf_(accf[mi][NIO + 0][i]), siluf_(accf[mi][NIO + 1][i])}; };
        stage_out<0>(wlds, lane, vf, (sect == 0 ? QHb : SZHb) + (size_t)mb * 1024 + cb, 1024);
      }
    };
    FOR_TILES_XCD(16, mt, nt) gemm_tile256(smem, tid, afn, wt_hg_in, 1024, mt * 256, nt * 256, epi);
  }
  }
  xcd_barrier(xb);

  float* bq = (float*)smem;
  u16* kT = (u16*)smem;
  u16* vT = (u16*)(smem + 34816);
  float* segs = (float*)(smem + 34816 + 18432);
  float* red = segs + 1024;

  PH(8) {
  REFRESH();
  for (int u = blockIdx.x; u < 4096; u += gridDim.x) {
    const int chunk = u & 255, h = (u >> 8) & 7, b = u >> 11;
    const int row0 = b * SEQ + chunk * 64;
    uint4 uvp[2];
#pragma unroll
    for (int sp2 = 0; sp2 < 2; ++sp2)
      uvp[sp2] = *(const uint4*)(VHb + (size_t)(row0 + (tid >> 4) + sp2 * 32) * 1024 + h * 128 + (tid & 15) * 8);
    float lf[16], bb[16], total;
    hg_scan(tid, LOGFb, row0, h, segs, lf, bb, total);
    {
      const int k = tid & 127, seg = tid >> 7;
      float kv[16];
#pragma unroll
      for (int i = 0; i < 16; ++i) kv[i] = (1.f - __expf(lf[i])) * __expf(total - bb[i]);
#pragma unroll
      for (int hh = 0; hh < 2; ++hh) {
        uint4 o;
        o.x = pack2(kv[hh * 8 + 0], kv[hh * 8 + 1]);
        o.y = pack2(kv[hh * 8 + 2], kv[hh * 8 + 3]);
        o.z = pack2(kv[hh * 8 + 4], kv[hh * 8 + 5]);
        o.w = pack2(kv[hh * 8 + 6], kv[hh * 8 + 7]);
        *(uint4*)(kT + k * 72 + seg * 16 + hh * 8) = o;
      }
      if (seg == 0) DCb[u * 128 + k] = __expf(total);
    }
#pragma unroll
    for (int sp2 = 0; sp2 < 2; ++sp2) {
      const int s = (tid >> 4) + sp2 * 32, v8 = (tid & 15) * 8;
      const uint4 uv = uvp[sp2];
      const unsigned a[4] = {uv.x, uv.y, uv.z, uv.w};
#pragma unroll
      for (int j = 0; j < 8; ++j) vT[(v8 + j) * 72 + s] = (u16)((j & 1) ? (a[j >> 1] >> 16) : (a[j >> 1] & 0xffffu));
    }
    __syncthreads();
    {
      const int c = lane & 15, q4 = lane >> 4;
      const int kt8 = wave;
      bf16x8 af[2];
#pragma unroll
      for (int ks = 0; ks < 2; ++ks) af[ks] = ld8(kT + (kt8 * 16 + c) * 72 + ks * 32 + q4 * 8);
#pragma unroll
      for (int vv = 0; vv < 8; ++vv) {
        const int vt = vv;
        f32x4 a = {0.f, 0.f, 0.f, 0.f};
#pragma unroll
        for (int ks = 0; ks < 2; ++ks) a = mfma16(af[ks], ld8(vT + (vt * 16 + c) * 72 + ks * 32 + q4 * 8), a);
        uint2 o;
        o.x = pack2(a[0], a[1]);
        o.y = pack2(a[2], a[3]);
        *(uint2*)(STb + ((size_t)u * 128 + vt * 16 + c) * 128 + kt8 * 16 + q4 * 4) = o;
      }
    }
    __syncthreads();
  }
  }
  xcd_barrier(xb);

  PH(9) {
  REFRESH();
  for (int e = gt; e < 131072; e += ngt) {
    const int bh = e >> 13, rem = e & 8191, v = rem >> 6, k2 = (rem & 63) * 2;
    float S0 = 0.f, S1 = 0.f;
    unsigned* sp = (unsigned*)(STb + ((size_t)(bh * 256) * 128 + v) * 128 + k2);
    const float* dp = DCb + (size_t)(bh * 256) * 128 + k2;
#pragma unroll 8
    for (int ch = 0; ch < 256; ++ch) {
      const unsigned a = sp[(size_t)ch * 8192];
      const float2 d = *(const float2*)(dp + ch * 128);
      sp[(size_t)ch * 8192] = pack2(S0, S1);
      S0 = d.x * S0 + bflo(a);
      S1 = d.y * S1 + bfhi(a);
    }
  }
  }
  xcd_barrier(xb);

  PH(10) {
  REFRESH();
  u16* kTl = (u16*)(smem + 58368);
  u16* qal = (u16*)(smem + 75776);
  u16* q1l = (u16*)(smem + 93184);
  for (int u = blockIdx.x; u < 4096; u += gridDim.x) {
    const int chunk = u & 255, h = (u >> 8) & 7, b = u >> 11;
    const int row0 = b * SEQ + chunk * 64;
    const int ps = tid >> 3, pk = (tid & 7) * 16;
    const uint4 uq0 = *(const uint4*)(QHb + (size_t)(row0 + ps) * 1024 + h * 128 + pk);
    const uint4 uq1 = *(const uint4*)(QHb + (size_t)(row0 + ps) * 1024 + h * 128 + pk + 8);
    uint4 uvp[2];
#pragma unroll
    for (int sp2 = 0; sp2 < 2; ++sp2)
      uvp[sp2] = *(const uint4*)(VHb + (size_t)(row0 + (tid >> 4) + sp2 * 32) * 1024 + h * 128 + (tid & 15) * 8);
    bf16x8 sfr[4][4];
    uint2 zzp[4];
    {
      const int c_ = lane & 15, q4_ = lane >> 4, I_ = wave >> 1, vq_ = wave & 1;
#pragma unroll
      for (int vv = 0; vv < 4; ++vv) {
        const u16* sp = STb + ((size_t)u * 128 + (vq_ * 4 + vv) * 16 + c_) * 128 + q4_ * 8;
#pragma unroll
        for (int kk = 0; kk < 4; ++kk) sfr[vv][kk] = ld8(sp + kk * 32);
        zzp[vv] = *(const uint2*)(SZHb + (size_t)(row0 + I_ * 16 + c_) * 1024 + h * 128 + (vq_ * 4 + vv) * 16 + q4_ * 4);
      }
    }
    {
      float lf[16], bb[16], total;
      hg_scan(tid, LOGFb, row0, h, segs, lf, bb, total);
      const int k = tid & 127, seg = tid >> 7;
#pragma unroll
      for (int i = 0; i < 16; ++i) bq[(seg * 16 + i) * 132 + k] = bb[i];
    }
#pragma unroll
    for (int sp2 = 0; sp2 < 2; ++sp2) {
      const int s = (tid >> 4) + sp2 * 32, v8 = (tid & 15) * 8;
      const uint4 uv = uvp[sp2];
      const unsigned a[4] = {uv.x, uv.y, uv.z, uv.w};
#pragma unroll
      for (int j = 0; j < 8; ++j) vT[(v8 + j) * 72 + s] = (u16)((j & 1) ? (a[j >> 1] >> 16) : (a[j >> 1] & 0xffffu));
    }
    __syncthreads();
    {
      const unsigned aq[8] = {uq0.x, uq0.y, uq0.z, uq0.w, uq1.x, uq1.y, uq1.z, uq1.w};
      const int spv = ps > 0 ? ps - 1 : 0;
      float kt_[16], qa_[16], q1_[16];
#pragma unroll
      for (int g4 = 0; g4 < 4; ++g4) {
        const float4 bs4 = *(const float4*)(bq + ps * 132 + pk + g4 * 4);
        const float4 bp4 = *(const float4*)(bq + spv * 132 + pk + g4 * 4);
        const float4 bm4 = *(const float4*)(bq + 31 * 132 + pk + g4 * 4);
        const float bsv[4] = {bs4.x, bs4.y, bs4.z, bs4.w};
        const float bpv[4] = {bp4.x, bp4.y, bp4.z, bp4.w};
        const float bmv[4] = {bm4.x, bm4.y, bm4.z, bm4.w};
#pragma unroll
        for (int jj = 0; jj < 4; ++jj) {
          const int j = g4 * 4 + jj;
          const float qv = (j & 1) ? bfhi(aq[j >> 1]) : bflo(aq[j >> 1]);
          const float bs = bsv[jj], bp = ps > 0 ? bpv[jj] : 0.f, bm = bmv[jj];
          kt_[j] = (1.f - __expf(bs - bp)) * __expf(bm - bs);
          qa_[j] = qv * __expf(bs - bm);
          q1_[j] = qv * __expf(bs);
        }
      }
#pragma unroll
      for (int hh = 0; hh < 2; ++hh) {
        uint4 o0, o1, o2;
        o0.x = pack2(kt_[hh * 8 + 0], kt_[hh * 8 + 1]);
        o0.y = pack2(kt_[hh * 8 + 2], kt_[hh * 8 + 3]);
        o0.z = pack2(kt_[hh * 8 + 4], kt_[hh * 8 + 5]);
        o0.w = pack2(kt_[hh * 8 + 6], kt_[hh * 8 + 7]);
        o1.x = pack2(qa_[hh * 8 + 0], qa_[hh * 8 + 1]);
        o1.y = pack2(qa_[hh * 8 + 2], qa_[hh * 8 + 3]);
        o1.z = pack2(qa_[hh * 8 + 4], qa_[hh * 8 + 5]);
        o1.w = pack2(qa_[hh * 8 + 6], qa_[hh * 8 + 7]);
        o2.x = pack2(q1_[hh * 8 + 0], q1_[hh * 8 + 1]);
        o2.y = pack2(q1_[hh * 8 + 2], q1_[hh * 8 + 3]);
        o2.z = pack2(q1_[hh * 8 + 4], q1_[hh * 8 + 5]);
        o2.w = pack2(q1_[hh * 8 + 6], q1_[hh * 8 + 7]);
        *(uint4*)(kTl + ps * 136 + pk + hh * 8) = o0;
        *(uint4*)(qal + ps * 136 + pk + hh * 8) = o1;
        *(uint4*)(q1l + ps * 136 + pk + hh * 8) = o2;
      }
    }
    __syncthreads();
    const int c = lane & 15, q4 = lane >> 4;
    const int I = wave >> 1, vq = wave & 1;
    const int t = I * 16 + c;
    f32x4 o[4];
#pragma unroll
    for (int vv = 0; vv < 4; ++vv) o[vv] = f32x4{0.f, 0.f, 0.f, 0.f};
    {
      bf16x8 q1[4], qa[4];
#pragma unroll
      for (int kk = 0; kk < 4; ++kk) {
        qa[kk] = ld8(qal + t * 136 + kk * 32 + q4 * 8);
        q1[kk] = ld8(q1l + t * 136 + kk * 32 + q4 * 8);
      }
      f32x4 at[4];
#pragma unroll
      for (int J = 0; J < 4; ++J) {
        at[J] = f32x4{0.f, 0.f, 0.f, 0.f};
        if (J <= I) {
#pragma unroll
          for (int kk = 0; kk < 4; ++kk) at[J] = mfma16(ld8(kTl + (J * 16 + c) * 136 + kk * 32 + q4 * 8), qa[kk], at[J]);
#pragma unroll
          for (int i = 0; i < 4; ++i)
            if (J * 16 + q4 * 4 + i > t) at[J][i] = 0.f;
        }
      }
#pragma unroll
      for (int a = 0; a < 2; ++a) {
        if (2 * a <= I) {
          const bf16x8 pb = pack8(at[2 * a], at[2 * a + 1]);
#pragma unroll
          for (int vv = 0; vv < 4; ++vv) {
            const u16* vp = vT + ((vq * 4 + vv) * 16 + c) * 72 + a * 32 + q4 * 4;
            o[vv] = mfma16(ld4x2(vp, vp + 16), pb, o[vv]);
          }
        }
      }
#pragma unroll
      for (int vv = 0; vv < 4; ++vv) {
#pragma unroll
        for (int kk = 0; kk < 4; ++kk) o[vv] = mfma16(sfr[vv][kk], q1[kk], o[vv]);
      }
    }
    {
      float ss = 0.f;
#pragma unroll
      for (int vv = 0; vv < 4; ++vv)
#pragma unroll
        for (int i = 0; i < 4; ++i) ss += o[vv][i] * o[vv][i];
      ss += __shfl_xor(ss, 16);
      ss += __shfl_xor(ss, 32);
      if (q4 == 0) red[t * 2 + vq] = ss;
    }
    __syncthreads();
    {
      const float tot = red[t * 2 + 0] + red[t * 2 + 1];
      const float rstd = rsqrtf(tot * (1.f / 128.f) + EPSV);
#pragma unroll
      for (int vv = 0; vv < 4; ++vv) {
        const int v0 = (vq * 4 + vv) * 16 + q4 * 4;
        const size_t idx = (size_t)(row0 + t) * 1024 + h * 128 + v0;
        const float4 gn = *(const float4*)(p.hg_norm + h * 128 + v0);
        const uint2 zz = zzp[vv];
        uint2 ov;
        ov.x = pack2(o[vv][0] * rstd * gn.x * bflo(zz.x), o[vv][1] * rstd * gn.y * bfhi(zz.x));
        ov.y = pack2(o[vv][2] * rstd * gn.z * bflo(zz.y), o[vv][3] * rstd * gn.w * bfhi(zz.y));
        *(uint2*)(QHb + idx) = ov;
      }
    }
    __syncthreads();
  }
  }
  xcd_barrier(xb);

  PH(11) {
  REFRESH();
  {
    auto afn = [&](int row, int k) { return QHb + (size_t)row * 1024 + k; };
    const int lane_ = lane;
    auto epi = [&](f32x16(&accf)[2][4], int mb, int nb, auto nio_) {
      constexpr int NIO = decltype(nio_)::value;
      int lane = lane_;
      asm volatile("" : "+v"(lane));
      stage_add_f32<NIO>(smem + wave * 16384, lane, accf, p.out + (size_t)mb * 1024 + nb, p.out + (size_t)mb * 1024 + nb, 1024);
    };
    FOR_TILES_XCD(4, mt, nt) gemm_tile256<false>(smem, tid, afn, wt_hg_out, 1024, mt * 256, nt * 256, epi);
  }
  }
  xcd_barrier(xb);

  PH(12) {
  REFRESH();
  for (int row0 = gw; row0 < NTOK; row0 += 4 * nw) {
    float4 v[4][4];
#pragma unroll
    for (int r = 0; r < 4; ++r) {
      const int row = row0 + r * nw < NTOK ? row0 + r * nw : row0;
      const float4* sp = (const float4*)(p.out + (size_t)row * 1024);
#pragma unroll
      for (int i = 0; i < 4; ++i) v[r][i] = sp[lane + 64 * i];
    }
#pragma unroll
    for (int r = 0; r < 4; ++r) {
      const int row = row0 + r * nw;
      if (row < NTOK) {
        float4* sp = (float4*)(p.out + (size_t)row * 1024);
        float ss = 0.f;
#pragma unroll
        for (int i = 0; i < 4; ++i) ss += v[r][i].x * v[r][i].x + v[r][i].y * v[r][i].y + v[r][i].z * v[r][i].z + v[r][i].w * v[r][i].w;
        ss = wave_sum(ss);
        const float rstd = rsqrtf(ss * (1.f / 1024.f) + EPSV);
#pragma unroll
        for (int i = 0; i < 4; ++i) {
          const float4 gg = ((const float4*)p.final_norm)[lane + 64 * i];
          sp[lane + 64 * i] = make_float4(v[r][i].x * rstd * gg.x, v[r][i].y * rstd * gg.y, v[r][i].z * rstd * gg.z, v[r][i].w * rstd * gg.w);
        }
      }
    }
  }
}
}

extern "C" void kernel_launch(void* const* d_in, const int* in_sizes, int n_in, void* d_out, int out_size, void* d_ws,
                              size_t ws_size, hipStream_t stream) {
  (void)in_sizes;
  (void)n_in;
  (void)out_size;
  if (ws_size < WS_NEED) {
    fprintf(stderr, "workspace too small: %zu < %zu\n", ws_size, (size_t)WS_NEED);
    return;
  }
  static int grid_blocks = 0;
  if (!grid_blocks) {
    int dev = 0, cus = 0, per_cu = 0;
    hipGetDevice(&dev);
    hipDeviceGetAttribute(&cus, hipDeviceAttributeMultiprocessorCount, dev);
    hipFuncSetAttribute((const void*)mega, hipFuncAttributeMaxDynamicSharedMemorySize, DYN_LDS);
    hipOccupancyMaxActiveBlocksPerMultiprocessor(&per_cu, mega, NTHR, DYN_LDS);
    if (per_cu < 1) per_cu = 1;
    if (per_cu > 1) per_cu = 1;
    grid_blocks = cus * per_cu;
  }
  Params p{};
  p.x = (const float*)d_in[0];
  p.norm_w = (const float*)d_in[1];
  p.nsa_w_in = (const float*)d_in[2];
  p.pe_k = (const float*)d_in[3];
  p.pe_v = (const float*)d_in[4];
  p.wk1 = (const float*)d_in[5];
  p.wk2 = (const float*)d_in[6];
  p.wv1 = (const float*)d_in[7];
  p.wv2 = (const float*)d_in[8];
  p.nsa_w_out = (const float*)d_in[9];
  p.hg_w_in = (const float*)d_in[10];
  p.lb_logits = (const float*)d_in[11];
  p.hg_norm = (const float*)d_in[12];
  p.hg_w_out = (const float*)d_in[13];
  p.final_norm = (const float*)d_in[14];
  p.out = (float*)d_out;
  p.ws = (char*)d_ws;
  hipMemsetAsync((char*)d_ws + OFF_MISC + 16384, 0, XCD_BAR_WORDS * sizeof(unsigned), stream);
  void* args[] = {&p};
  hipError_t e = hipLaunchCooperativeKernel((void*)mega, dim3(grid_blocks), dim3(NTHR), args, DYN_LDS, stream);
  if (e != hipSuccess) fprintf(stderr, "cooperative launch failed: %s (grid %d)\n", hipGetErrorString(e), grid_blocks);
}
```
